# Optimizing an MI355X kernel written in HIP

```python
import math
import jax, jax.numpy as jnp
from jax import lax
import numpy as np

D_MODEL = 1024
BATCH = 4
SEQ = 8192
DEPTH = 2

CHUNK = 64
Q_BLOCK = 128
SB_HEADS = 8
SB_HEAD_DIM = 64
SB_WIDTH = SB_HEADS * SB_HEAD_DIM
SSM_WIDTH = D_MODEL // 2
SSM_GROUP = 16
SSM_GROUPS = SSM_WIDTH // SSM_GROUP
SSM_STATE = 64
DT_MIN = 1e-3
DT_MAX = 1e-1
FFN_HIDDEN = ((8 * D_MODEL // 3 + 255) // 256) * 256
IN_SPLITS = (SB_WIDTH, 2 * SB_WIDTH, 3 * SB_WIDTH, 3 * SB_WIDTH + SSM_WIDTH,
             3 * SB_WIDTH + SSM_WIDTH + D_MODEL)
IN_COLS = 3 * SB_WIDTH + SSM_WIDTH + 2 * D_MODEL
N_MOD = 6
DEEPNORM_ALPHA = (2 * DEPTH) ** 0.25
DEEPNORM_BETA = (8 * DEPTH) ** -0.25
LN_EPS = 1e-5

kernel_name = "hybrid_sb_s5_deepnorm_adaln"


def _normalize(x):
    xf = x.astype(jnp.float32)
    mu = jnp.mean(xf, axis=-1, keepdims=True)
    var = jnp.mean(jnp.square(xf - mu), axis=-1, keepdims=True)
    return ((xf - mu) * lax.rsqrt(var + LN_EPS)).astype(x.dtype)


def _layer_norm(x, g, b):
    return _normalize(x) * g + b


def stick_breaking_attention(q, k, v):
    b, s, h, dh = q.shape
    nb = s // Q_BLOCK
    f32 = jnp.float32
    qb = q.astype(f32).reshape(b, nb, Q_BLOCK, h, dh).transpose(1, 0, 3, 2, 4)
    kt = k.astype(f32).transpose(0, 2, 1, 3)
    vt = v.astype(f32).transpose(0, 2, 1, 3)
    key_pos = jnp.arange(s, dtype=jnp.int32)
    scale = 1.0 / math.sqrt(dh)

    def one_block(args):
        q_blk, blk = args
        q_pos = blk * Q_BLOCK + jnp.arange(Q_BLOCK, dtype=jnp.int32)
        z = jnp.einsum('bhqd,bhkd->bhqk', q_blk, kt) * scale
        causal = key_pos[None, :] < q_pos[:, None]
        log_beta = jax.nn.log_sigmoid(z)
        log_one_minus = jnp.where(causal, log_beta - z, 0.0)
        after = lax.cumsum(log_one_minus, axis=3, reverse=True) - log_one_minus
        w = jnp.where(causal, jnp.exp(log_beta + after), 0.0)
        return jnp.einsum('bhqk,bhkd->bhqd', w, vt)

    out = lax.map(one_block, (qb, jnp.arange(nb, dtype=jnp.int32)))
    return out.transpose(1, 0, 3, 2, 4).reshape(b, s, h * dh).astype(v.dtype)


def s5_branch(u, a_re, a_im, log_dt, b_re, b_im, c_re, c_im, d_skip, w_glu, b_glu):
    f32 = jnp.float32
    c64 = jnp.complex64
    bsz, s, _ = u.shape
    n_chunks = s // CHUNK
    uf = u.astype(f32)
    lam = lax.complex(a_re.astype(f32), a_im.astype(f32))
    dt = jnp.exp(log_dt.astype(f32))[:, None]
    lam_dt = lam * dt
    lam_bar = jnp.exp(lam_dt)
    b_mat = lax.complex(b_re.astype(f32), b_im.astype(f32))
    b_bar = ((lam_bar - 1.0) / lam)[..., None] * b_mat
    c_mat = lax.complex(c_re.astype(f32), c_im.astype(f32))
    steps = jnp.arange(1, CHUNK + 1, dtype=f32)
    powers = jnp.exp(lam_dt[None] * steps[:, None, None].astype(c64))
    a_seq = jnp.broadcast_to(lam_bar[None, None], (CHUNK, bsz, SSM_GROUPS, SSM_STATE))

    u_chunks = uf.reshape(bsz, n_chunks, CHUNK, SSM_GROUPS, SSM_GROUP).transpose(1, 2, 0, 3, 4)

    def combine(left, right):
        a_l, b_l = left
        a_r, b_r = right
        return a_r * a_l, a_r * b_l + b_r

    def step(state, u_c):
        bu = jnp.einsum('gpc,lbgc->lbgp', b_bar, u_c.astype(c64))
        _, h_loc = lax.associative_scan(combine, (a_seq, bu), axis=0)
        h = h_loc + powers[:, None] * state[None]
        y = jnp.einsum('gcp,lbgp->lbgc', c_mat, h).real
        return h[-1], y

    state0 = jnp.zeros((bsz, SSM_GROUPS, SSM_STATE), c64)
    _, ys = lax.scan(step, state0, u_chunks)
    y = ys.transpose(2, 0, 1, 3, 4).reshape(bsz, s, SSM_WIDTH)
    y = y + d_skip.astype(f32) * uf
    y = jax.nn.gelu(y)
    y = y * jax.nn.sigmoid(y @ w_glu.astype(f32) + b_glu.astype(f32))
    return y.astype(u.dtype)


def token_mixer(h, w_in, w_sb_up, a_re, a_im, log_dt, b_re, b_im, c_re, c_im,
                d_skip, w_glu, b_glu, w_ssm_up, w_out):
    bsz, s, _ = h.shape
    proj = h @ w_in
    q, k, v, u, g_sb, g_ssm = jnp.split(proj, IN_SPLITS, axis=-1)
    shp = (bsz, s, SB_HEADS, SB_HEAD_DIM)
    y_sb = stick_breaking_attention(q.reshape(shp), k.reshape(shp), v.reshape(shp)) @ w_sb_up
    y_ssm = s5_branch(u, a_re, a_im, log_dt, b_re, b_im, c_re, c_im,
                      d_skip, w_glu, b_glu) @ w_ssm_up
    merged = jax.nn.sigmoid(g_sb) * y_sb + jax.nn.sigmoid(g_ssm) * y_ssm
    return merged @ w_out


def swiglu_ffn(h, w_ffn_in, w_ffn_out):
    gate, up = jnp.split(h @ w_ffn_in, 2, axis=-1)
    return (jax.nn.silu(gate) * up) @ w_ffn_out


def setup_inputs(seed: int = 0) -> dict:
    key = jax.random.key(seed)
    ks = jax.random.split(key, 32)
    f32 = jnp.float32

    def nrm(k, shape, scale):
        return jax.random.normal(k, shape, f32) * scale

    G, P, Cg = SSM_GROUPS, SSM_STATE, SSM_GROUP
    n = jnp.arange(P, dtype=f32)
    return {
        "x": nrm(ks[0], (BATCH, SEQ, D_MODEL), 1.0),
        "c": nrm(ks[1], (BATCH, D_MODEL), 1.0),
        "w_ada": nrm(ks[2], (DEPTH, D_MODEL, N_MOD * D_MODEL), 0.5 * D_MODEL ** -0.5),
        "b_ada": nrm(ks[3], (DEPTH, N_MOD * D_MODEL), 0.02),
        "w_in": nrm(ks[4], (DEPTH, D_MODEL, IN_COLS), D_MODEL ** -0.5),
        "w_sb_up": nrm(ks[5], (DEPTH, SB_WIDTH, D_MODEL), SB_WIDTH ** -0.5),
        "ssm_a_re": -0.5 + nrm(ks[6], (DEPTH, G, P), 0.01),
        "ssm_a_im": math.pi * n + nrm(ks[7], (DEPTH, G, P), 0.01),
        "ssm_log_dt": jax.random.uniform(ks[8], (DEPTH, G), f32,
                                         math.log(DT_MIN), math.log(DT_MAX)),
        "ssm_b_re": nrm(ks[9], (DEPTH, G, P, Cg), (2 * Cg) ** -0.5),
        "ssm_b_im": nrm(ks[10], (DEPTH, G, P, Cg), (2 * Cg) ** -0.5),
        "ssm_c_re": nrm(ks[11], (DEPTH, G, Cg, P), P ** -0.5),
        "ssm_c_im": nrm(ks[12], (DEPTH, G, Cg, P), P ** -0.5),
        "ssm_d": 1.0 + nrm(ks[13], (DEPTH, SSM_WIDTH), 0.1),
        "w_glu": nrm(ks[14], (DEPTH, SSM_WIDTH, SSM_WIDTH), SSM_WIDTH ** -0.5),
        "b_glu": nrm(ks[15], (DEPTH, SSM_WIDTH), 0.02),
        "w_ssm_up": nrm(ks[16], (DEPTH, SSM_WIDTH, D_MODEL), SSM_WIDTH ** -0.5),
        "w_out": nrm(ks[17], (DEPTH, D_MODEL, D_MODEL), D_MODEL ** -0.5 * DEEPNORM_BETA),
        "ln1_g": 1.0 + nrm(ks[18], (DEPTH, D_MODEL), 0.02),
        "ln1_b": nrm(ks[19], (DEPTH, D_MODEL), 0.02),
        "w_ffn_in": nrm(ks[20], (DEPTH, D_MODEL, 2 * FFN_HIDDEN), D_MODEL ** -0.5),
        "w_ffn_out": nrm(ks[21], (DEPTH, FFN_HIDDEN, D_MODEL), FFN_HIDDEN ** -0.5 * DEEPNORM_BETA),
        "ln2_g": 1.0 + nrm(ks[22], (DEPTH, D_MODEL), 0.02),
        "ln2_b": nrm(ks[23], (DEPTH, D_MODEL), 0.02),
    }


def reference(x, c, w_ada, b_ada, w_in, w_sb_up, ssm_a_re, ssm_a_im, ssm_log_dt,
              ssm_b_re, ssm_b_im, ssm_c_re, ssm_c_im, ssm_d, w_glu, b_glu,
              w_ssm_up, w_out, ln1_g, ln1_b, w_ffn_in, w_ffn_out, ln2_g, ln2_b):
    c_act = jax.nn.silu(c)
    for l in range(DEPTH):
        mod = c_act @ w_ada[l] + b_ada[l]
        sh_m, sc_m, g_m, sh_f, sc_f, g_f = [m[:, None, :] for m in jnp.split(mod, N_MOD, axis=-1)]
        h = _normalize(x) * (1.0 + sc_m) + sh_m
        y = token_mixer(h, w_in[l], w_sb_up[l], ssm_a_re[l], ssm_a_im[l], ssm_log_dt[l],
                        ssm_b_re[l], ssm_b_im[l], ssm_c_re[l], ssm_c_im[l], ssm_d[l],
                        w_glu[l], b_glu[l], w_ssm_up[l], w_out[l])
        x = _layer_norm(DEEPNORM_ALPHA * x + (1.0 + g_m) * y, ln1_g[l], ln1_b[l])
        h = _normalize(x) * (1.0 + sc_f) + sh_f
        y = swiglu_ffn(h, w_ffn_in[l], w_ffn_out[l])
        x = _layer_norm(DEEPNORM_ALPHA * x + (1.0 + g_f) * y, ln2_g[l], ln2_b[l])
    return x
```

```cpp
#include <hip/hip_runtime.h>
#include <hip/hip_cooperative_groups.h>
#include <cstdio>
#include <cstdint>
namespace cg = cooperative_groups;

#define LAS __attribute__((address_space(3)))
typedef _Float16 f16;
typedef _Float16 f16x8 __attribute__((ext_vector_type(8)));
typedef _Float16 f16x4 __attribute__((ext_vector_type(4)));
typedef float f32x4 __attribute__((ext_vector_type(4)));
typedef float f32x16 __attribute__((ext_vector_type(16)));

constexpr int D = 1024, NB = 4, SEQ = 8192, M = NB * SEQ, NMOD = 6 * D;
constexpr int INC = 4096, FH = 2816;
constexpr float ALPHA = 1.41421356237309515f;
constexpr float LN_EPS = 1e-5f;
constexpr size_t MiB = 1u << 20;
constexpr size_t WS_WL = 29 * MiB;
constexpr size_t W_IN = 0, W_SBUP = 8 * MiB, W_GLU = 9 * MiB, W_SSMUP = 9 * MiB + MiB / 2, W_OUT = 10 * MiB + MiB / 2, W_FIN = 12 * MiB + MiB / 2, W_FOUT = 23 * MiB + MiB / 2;
constexpr size_t WS_SSM = 58 * MiB, WS_SSML = 10 * MiB + MiB / 2;
constexpr size_t S_TW = 0, S_W1 = 6 * MiB, S_KD = 10 * MiB;
constexpr size_t WS_MOD = 79 * MiB;
constexpr size_t MOD_BYTES = 2 * 4 * 6144 * 4;
constexpr size_t WS_XN = 80 * MiB;
constexpr size_t WS_Q = 144 * MiB, WS_K = 176 * MiB, WS_VT = 208 * MiB, WS_UG = 240 * MiB, WS_SG = 288 * MiB, WS_O = 416 * MiB, WS_S = 448 * MiB, WS_YS = 480 * MiB;
constexpr size_t WS_S5 = WS_Q, WS_TMP = WS_K, WS_MRG = WS_O;
constexpr size_t WS_H = 144 * MiB, WS_R2 = 320 * MiB;
constexpr size_t WS_NEED = 512 * MiB;
constexpr int LDS_BYTES = 147456;

namespace pg8 {
constexpr int BM = 256, BK = 64, HALF = 128, HTB = HALF * BK * 2, NXCD = 8, WGM = 8;
__host__ __device__ __forceinline__ int lds_byte(int r, int c) { const int st = (r >> 4) * 2 + (c >> 5), rr = r & 15, cc = c & 31, ob = rr * 64 + cc * 2; return st * 1024 + (ob ^ (((ob >> 9) & 1) << 5)); }
__host__ __device__ __forceinline__ void stage_rc(int b, int& R, int& C) { const int st = b / 1024, sb = b % 1024, swz = sb ^ (((sb >> 9) & 1) << 5); R = (st >> 1) * 16 + swz / 64; C = (st & 1) * 32 + (swz % 64) / 2; }

struct Unit { int pm, pn; };
struct Gemm { const f16* A; const f16* Bt; int K, lda, ldb; };

struct StaticOrder {
    int nM, nN, nwg, G, c;
    __device__ void init(int M_, int N_, int G_, int c_) { nM = M_ / BM; nN = N_ / BM; nwg = nM * nN; G = G_; c = c_; }
    __device__ bool next(int i, Unit& u) const {
        const long L = (long)i * G + c; if (L >= nwg) return false;
        int wgid = (int)L; { const int q = nwg / NXCD, r = nwg % NXCD, xcd = wgid % NXCD, off = wgid / NXCD; wgid = (xcd < r ? xcd * (q + 1) : r * (q + 1) + (xcd - r) * q) + off; }
        const int nig = WGM * nN, gid = wgid / nig, fm = gid * WGM, gsz = (nM - fm) < WGM ? (nM - fm) : WGM;
        u.pm = fm + ((wgid % nig) % gsz); u.pn = (wgid % nig) / gsz; return true;
    }
};
struct GroupOrder {
    int G, c;
    __device__ bool next(int i, Unit& u) const { const int L = i * G + c; if (L >= 256) return false; u.pm = L; u.pn = L >> 3; return true; }
};

template <class Epi, class Sched, bool ALIGN_EPI>
__device__ __forceinline__ void gemm_phase(LAS unsigned char* lds, const Gemm g, const Sched& S, const Epi& E, int wid_in) {
    int tid = (wid_in << 6) | (int)__builtin_amdgcn_mbcnt_hi(~0u, __builtin_amdgcn_mbcnt_lo(~0u, 0u)); asm volatile("" : "+v"(tid));
    const int wid = __builtin_amdgcn_readfirstlane(tid >> 6), lane = tid & 63, wr = wid >> 2, wc = wid & 3, fr = lane & 15, fq = lane >> 4;
    const int K = g.K, nt = K / BK;
    unsigned voffA[2], voffB[2];
#pragma unroll
    for (int i = 0; i < 2; ++i) { int R, C; stage_rc(tid * 16 + i * 8192, R, C);
        voffA[i] = (unsigned)(R * g.lda + C) * 2u; voffB[i] = (unsigned)(R * g.ldb + C) * 2u; }
    const size_t kstep = (size_t)(BK * 2);
    const size_t hstepA = (size_t)HALF * g.lda * 2, hstepB = (size_t)HALF * g.ldb * 2;
    const size_t tstepA = 2 * hstepA, tstepB = 2 * hstepB;
    const unsigned ldsw = (unsigned)wid * 1024u;
    const int aoff = lds_byte(wr * 64 + fr, fq * 8), boff = lds_byte(wc * 32 + fr, fq * 8);
#define PG8_SA(b, h) (((b) * 2 + (h)) * HTB)
#define PG8_SB(b, h) ((4 + (b) * 2 + (h)) * HTB)
#define PG8_STAGE(bufoff, gbase, voff) do { _Pragma("unroll") for (int _i = 0; _i < 2; ++_i) \
        __builtin_amdgcn_global_load_lds((const unsigned*)((const char*)(gbase) + (voff)[_i]), (LAS unsigned*)(lds + (bufoff) + ldsw + _i * 8192), 16, 0, 0); } while (0)
#define PG8_LDA(dst, b, h) do { _Pragma("unroll") for (int m = 0; m < 4; ++m) _Pragma("unroll") for (int k = 0; k < 2; ++k) dst[m][k] = *(const LAS f16x8*)(lds + PG8_SA(b, h) + aoff + m * 2048 + k * 1024); } while (0)
#define PG8_LDB(dst, b, h) do { _Pragma("unroll") for (int n = 0; n < 2; ++n) _Pragma("unroll") for (int k = 0; k < 2; ++k) dst[n][k] = *(const LAS f16x8*)(lds + PG8_SB(b, h) + boff + n * 2048 + k * 1024); } while (0)
#define PG8_MMA(ai, bj, At, Bt) do { __builtin_amdgcn_s_setprio(1); _Pragma("unroll") for (int m = 0; m < 4; ++m) _Pragma("unroll") for (int n = 0; n < 2; ++n) _Pragma("unroll") for (int k = 0; k < 2; ++k) \
        acc[ai][bj][m][n] = __builtin_amdgcn_mfma_f32_16x16x32_f16(Bt[n][k], At[m][k], acc[ai][bj][m][n], 0, 0, 0); __builtin_amdgcn_s_setprio(0); } while (0)
#define PG8_WAIT_V(n) asm volatile("s_waitcnt vmcnt(" #n ")" ::: "memory")
#define PG8_WAIT_L(n) asm volatile("s_waitcnt lgkmcnt(" #n ")" ::: "memory")
#define PG8_BAR __builtin_amdgcn_s_barrier()
#define PG8_SCHED __builtin_amdgcn_sched_barrier(0)
    Unit cur, nxt; int ui = 0;
    if (!S.next(0, cur)) return;
    f32x4 acc[2][2][4][2];
#pragma unroll
    for (int a = 0; a < 2; ++a)
#pragma unroll
        for (int b = 0; b < 2; ++b)
#pragma unroll
            for (int m = 0; m < 4; ++m)
#pragma unroll
                for (int n = 0; n < 2; ++n) acc[a][b][m][n] = (f32x4){0.f, 0.f, 0.f, 0.f};
    f16x8 At[4][2], B0[2][2], B1[2][2];
    const char* cA = (const char*)g.A + (size_t)cur.pm * tstepA; const char* cB = (const char*)g.Bt + (size_t)cur.pn * tstepB;
    PG8_STAGE(PG8_SB(0, 0), cB, voffB); PG8_STAGE(PG8_SB(0, 1), cB + hstepB, voffB); PG8_STAGE(PG8_SA(0, 0), cA, voffA); PG8_STAGE(PG8_SA(0, 1), cA + hstepA, voffA);
    if (wr == 1) PG8_BAR;
    PG8_WAIT_V(2); PG8_BAR;
    PG8_STAGE(PG8_SB(1, 0), cB + kstep, voffB); PG8_STAGE(PG8_SA(1, 0), cA + kstep, voffA); PG8_STAGE(PG8_SB(1, 1), cB + hstepB + kstep, voffB);
    PG8_WAIT_V(6); PG8_BAR;
    for (;;) {
        const bool has_next = S.next(ui + 1, nxt);
        const char* nA = has_next ? (const char*)g.A + (size_t)nxt.pm * tstepA : cA; const char* nB = has_next ? (const char*)g.Bt + (size_t)nxt.pn * tstepB : cB;
        for (int t = 0; t < nt; t += 2) {
            const bool last = (t == nt - 2);
            const char* a1 = cA + (size_t)(t + 1) * kstep;
            const char* a2 = last ? nA : cA + (size_t)(t + 2) * kstep; const char* b2 = last ? nB : cB + (size_t)(t + 2) * kstep;
            const char* a3 = a2 + kstep; const char* b3 = b2 + kstep;
            PG8_LDB(B0, 0, 0); PG8_LDB(B1, 0, 1); PG8_SCHED; PG8_LDA(At, 0, 0); PG8_STAGE(PG8_SA(1, 1), a1 + hstepA, voffA);
            PG8_WAIT_V(8); PG8_WAIT_L(0); PG8_BAR; PG8_MMA(0, 0, At, B0); PG8_MMA(0, 1, At, B1); PG8_BAR; PG8_SCHED;
            PG8_LDA(At, 0, 1); PG8_STAGE(PG8_SB(0, 0), b2, voffB); PG8_STAGE(PG8_SB(0, 1), b2 + hstepB, voffB); PG8_STAGE(PG8_SA(0, 0), a2, voffA);
            PG8_WAIT_V(8); PG8_WAIT_L(0); PG8_BAR; PG8_MMA(1, 0, At, B0); PG8_MMA(1, 1, At, B1); PG8_BAR; PG8_SCHED;
            PG8_LDB(B0, 1, 0); PG8_LDB(B1, 1, 1); PG8_SCHED; PG8_LDA(At, 1, 0); PG8_STAGE(PG8_SA(0, 1), a2 + hstepA, voffA);
            PG8_WAIT_V(8); PG8_WAIT_L(0); PG8_BAR; PG8_MMA(0, 0, At, B0); PG8_MMA(0, 1, At, B1); PG8_BAR; PG8_SCHED;
            PG8_LDA(At, 1, 1); PG8_STAGE(PG8_SB(1, 0), b3, voffB); PG8_STAGE(PG8_SB(1, 1), b3 + hstepB, voffB); PG8_STAGE(PG8_SA(1, 0), a3, voffA);
            PG8_WAIT_V(8); PG8_WAIT_L(0); PG8_BAR; PG8_MMA(1, 0, At, B0); PG8_MMA(1, 1, At, B1); PG8_BAR; PG8_SCHED;
        }
        if constexpr (ALIGN_EPI) { if (wr == 0) PG8_BAR; }
        { int l2 = (int)__builtin_amdgcn_mbcnt_hi(~0u, __builtin_amdgcn_mbcnt_lo(~0u, 0u)); asm volatile("" : "+v"(l2));
          E(acc, cur, wr, wc, l2 & 15, l2 >> 4); }
        if (!has_next) break;
#pragma unroll
        for (int a = 0; a < 2; ++a)
#pragma unroll
            for (int b = 0; b < 2; ++b)
#pragma unroll
                for (int m = 0; m < 4; ++m)
#pragma unroll
                    for (int n = 0; n < 2; ++n) acc[a][b][m][n] = (f32x4){0.f, 0.f, 0.f, 0.f};
        cur = nxt; cA = nA; cB = nB; ++ui;
        if constexpr (ALIGN_EPI) { if (wr == 1) PG8_BAR; }
    }
    PG8_WAIT_V(0);
    if constexpr (!ALIGN_EPI) { if (wr == 0) PG8_BAR; }
    PG8_BAR;
#undef PG8_SA
#undef PG8_SB
#undef PG8_STAGE
#undef PG8_LDA
#undef PG8_LDB
#undef PG8_MMA
#undef PG8_WAIT_V
#undef PG8_WAIT_L
#undef PG8_BAR
#undef PG8_SCHED
}
}
using pg8::Unit;
typedef const f32x4 (&AccRef)[2][2][4][2];

__device__ __forceinline__ float sigmoidf_(float x) { return 1.0f / (1.0f + __expf(-x)); }
__device__ __forceinline__ float gelu_tanh(float y) { const float t = 0.7978845608028654f * (y + 0.044715f * y * y * y); const float e = __expf(2.0f * t); const float th = 1.0f - 2.0f / (e + 1.0f); return 0.5f * y * (1.0f + th); }
__device__ __forceinline__ f16x4 cvt4(f32x4 v) { f16x4 o; o[0] = (f16)v[0]; o[1] = (f16)v[1]; o[2] = (f16)v[2]; o[3] = (f16)v[3]; return o; }
__device__ __forceinline__ float wave_sum(float v) {
#pragma unroll
    for (int o = 1; o < 64; o <<= 1) v += __shfl_xor(v, o);
    return v;
}
__device__ __forceinline__ void cexp_k(float re, float im, float k, float& er, float& ei) {
    const float mag = expf(k * re);
    float turns = k * im * 0.15915494309189535f; turns -= rintf(turns);
    const float ang = turns * 6.283185307179586f;
    er = mag * cosf(ang); ei = mag * sinf(ang);
}

struct EpiInProj {
    f16* Q; f16* Kb; f16* VT; f16* Ug; f16* SG;
    __device__ __forceinline__ void operator()(AccRef acc, const Unit& u, int wr, int wc, int fr, int fq) const {
        const int pn = u.pn, row0 = u.pm * 256 + wr * 64 + fr, cl0 = wc * 32 + 4 * fq;
        if (pn < 4) {
            f16* base = (pn < 2 ? Q : Kb) + (pn & 1) * 256 + cl0;
#pragma unroll
            for (int ai = 0; ai < 2; ++ai)
#pragma unroll
                for (int m = 0; m < 4; ++m) { f16* rp = base + (size_t)(row0 + ai * 128 + m * 16) * 512;
#pragma unroll
                    for (int bj = 0; bj < 2; ++bj)
#pragma unroll
                        for (int n = 0; n < 2; ++n) *(f16x4*)(rp + bj * 128 + n * 16) = cvt4(acc[ai][bj][m][n]); }
        } else if (pn < 6) {
#pragma unroll
            for (int ai = 0; ai < 2; ++ai)
#pragma unroll
                for (int m = 0; m < 4; ++m) { const int row = row0 + ai * 128 + m * 16, b = row >> 13, s = row & 8191;
#pragma unroll
                    for (int bj = 0; bj < 2; ++bj)
#pragma unroll
                        for (int n = 0; n < 2; ++n) { const int col = (pn - 4) * 256 + bj * 128 + n * 16 + cl0;
#pragma unroll
                            for (int j = 0; j < 4; ++j) VT[(size_t)(b * 512 + col + j) * 8192 + s] = (f16)acc[ai][bj][m][n][j]; } }
        } else if (pn < 8) {
#pragma unroll
            for (int ai = 0; ai < 2; ++ai)
#pragma unroll
                for (int m = 0; m < 4; ++m) { const int chunk = u.pm * 16 + ai * 8 + wr * 4 + m;
#pragma unroll
                    for (int bj = 0; bj < 2; ++bj)
#pragma unroll
                        for (int n = 0; n < 2; ++n) { const int g = (pn - 6) * 16 + bj * 8 + wc * 2 + n;
                            *(f16x4*)(Ug + (size_t)(g * 2048 + chunk) * 384 + fr * 16 + 4 * fq) = cvt4(acc[ai][bj][m][n]); } }
        } else {
            f16* base = SG + (pn - 8) * 256 + cl0;
#pragma unroll
            for (int ai = 0; ai < 2; ++ai)
#pragma unroll
                for (int m = 0; m < 4; ++m) { f16* rp = base + (size_t)(row0 + ai * 128 + m * 16) * 2048;
#pragma unroll
                    for (int bj = 0; bj < 2; ++bj)
#pragma unroll
                        for (int n = 0; n < 2; ++n) { const f32x4 v = acc[ai][bj][m][n]; f32x4 s; s[0] = sigmoidf_(v[0]); s[1] = sigmoidf_(v[1]); s[2] = sigmoidf_(v[2]); s[3] = sigmoidf_(v[3]);
                            *(f16x4*)(rp + bj * 128 + n * 16) = cvt4(s); } }
        }
    }
};
struct EpiSsm1 {
    float* S;
    __device__ __forceinline__ void operator()(AccRef acc, const Unit& u, int wr, int wc, int fr, int fq) const {
        const int row0 = u.pm * 256 + wr * 64 + fr;
#pragma unroll
        for (int ai = 0; ai < 2; ++ai)
#pragma unroll
            for (int m = 0; m < 4; ++m) { float* rp = S + (size_t)(row0 + ai * 128 + m * 16) * 128 + wc * 32 + 4 * fq;
#pragma unroll
                for (int n = 0; n < 2; ++n) *(f32x4*)(rp + n * 16) = acc[ai][0][m][n]; }
    }
};
struct EpiSsm3 {
    const f16* Ug; const float* dskip; f16* YS;
    __device__ __forceinline__ void operator()(AccRef acc, const Unit& u, int wr, int wc, int fr, int fq) const {
        const int g = u.pn, trow0 = u.pm * 256 + wr * 64 + fr;
        const f32x4 dv = *(const f32x4*)(dskip + 16 * g + 4 * fq);
#pragma unroll
        for (int ai = 0; ai < 2; ++ai)
#pragma unroll
            for (int m = 0; m < 4; ++m) { const int trow = trow0 + ai * 128 + m * 16, chunk = trow - g * 2048;
#pragma unroll
                for (int bj = 0; bj < 2; ++bj)
#pragma unroll
                    for (int n = 0; n < 2; ++n) { const int i = bj * 8 + wc * 2 + n;
                        const f16x4 uv = *(const f16x4*)(Ug + (size_t)trow * 384 + i * 16 + 4 * fq);
                        const f32x4 a = acc[ai][bj][m][n]; f32x4 y;
#pragma unroll
                        for (int j = 0; j < 4; ++j) y[j] = gelu_tanh(a[j] + dv[j] * (float)uv[j]);
                        *(f16x4*)(YS + (size_t)(chunk * 16 + i) * 512 + 16 * g + 4 * fq) = cvt4(y); } }
    }
};
struct EpiGlu {
    const f16* YS; const float* bias; f16* S5;
    __device__ __forceinline__ void operator()(AccRef acc, const Unit& u, int wr, int wc, int fr, int fq) const {
        const int row0 = u.pm * 256 + wr * 64 + fr, col0 = u.pn * 256 + wc * 32 + 4 * fq;
#pragma unroll
        for (int ai = 0; ai < 2; ++ai)
#pragma unroll
            for (int m = 0; m < 4; ++m) { const size_t ro = (size_t)(row0 + ai * 128 + m * 16) * 512;
#pragma unroll
                for (int bj = 0; bj < 2; ++bj)
#pragma unroll
                    for (int n = 0; n < 2; ++n) { const int col = col0 + bj * 128 + n * 16; const f32x4 bv = *(const f32x4*)(bias + col); const f16x4 yv = *(const f16x4*)(YS + ro + col);
                        const f32x4 a = acc[ai][bj][m][n]; f32x4 o;
#pragma unroll
                        for (int j = 0; j < 4; ++j) o[j] = (float)yv[j] * sigmoidf_(a[j] + bv[j]);
                        *(f16x4*)(S5 + ro + col) = cvt4(o); } }
    }
};
template <bool ADD> struct EpiUp {
    const f16* SG; int goff; const f16* T; f16* O;
    __device__ __forceinline__ void operator()(AccRef acc, const Unit& u, int wr, int wc, int fr, int fq) const {
        const int row0 = u.pm * 256 + wr * 64 + fr, col0 = u.pn * 256 + wc * 32 + 4 * fq;
#pragma unroll
        for (int ai = 0; ai < 2; ++ai)
#pragma unroll
            for (int m = 0; m < 4; ++m) { const size_t row = (size_t)(row0 + ai * 128 + m * 16);
#pragma unroll
                for (int bj = 0; bj < 2; ++bj)
#pragma unroll
                    for (int n = 0; n < 2; ++n) { const int col = col0 + bj * 128 + n * 16; const f16x4 gv = *(const f16x4*)(SG + row * 2048 + goff + col);
                        const f32x4 a = acc[ai][bj][m][n]; f32x4 o;
#pragma unroll
                        for (int j = 0; j < 4; ++j) o[j] = (float)gv[j] * a[j];
                        if (ADD) { const f16x4 tv = *(const f16x4*)(T + row * 1024 + col);
#pragma unroll
                            for (int j = 0; j < 4; ++j) o[j] += (float)tv[j]; }
                        *(f16x4*)(O + row * 1024 + col) = cvt4(o); } }
    }
};
struct EpiRes {
    const float* X; const float* gate; float* R;
    __device__ __forceinline__ void operator()(AccRef acc, const Unit& u, int wr, int wc, int fr, int fq) const {
        const int row0 = u.pm * 256 + wr * 64 + fr, col0 = u.pn * 256 + wc * 32 + 4 * fq;
        const float* gp = gate + (size_t)((u.pm * 256) >> 13) * NMOD;
        f32x4 gv[2][2];
#pragma unroll
        for (int bj = 0; bj < 2; ++bj)
#pragma unroll
            for (int n = 0; n < 2; ++n) gv[bj][n] = *(const f32x4*)(gp + col0 + bj * 128 + n * 16) + 1.0f;
#pragma unroll
        for (int ai = 0; ai < 2; ++ai)
#pragma unroll
            for (int m = 0; m < 4; ++m) { const size_t ro = (size_t)(row0 + ai * 128 + m * 16) * 1024;
#pragma unroll
                for (int bj = 0; bj < 2; ++bj)
#pragma unroll
                    for (int n = 0; n < 2; ++n) { const int col = col0 + bj * 128 + n * 16; const f32x4 xv = *(const f32x4*)(X + ro + col);
                        *(f32x4*)(R + ro + col) = xv * ALPHA + gv[bj][n] * acc[ai][bj][m][n]; } }
    }
};
struct EpiFfnIn {
    f16* H;
    __device__ __forceinline__ void operator()(AccRef acc, const Unit& u, int wr, int wc, int fr, int fq) const {
        const int row0 = u.pm * 256 + wr * 64 + fr, col0 = u.pn * 128 + wc * 32 + 4 * fq;
#pragma unroll
        for (int ai = 0; ai < 2; ++ai)
#pragma unroll
            for (int m = 0; m < 4; ++m) { f16* rp = H + (size_t)(row0 + ai * 128 + m * 16) * FH + col0;
#pragma unroll
                for (int n = 0; n < 2; ++n) { const f32x4 gt = acc[ai][0][m][n], up = acc[ai][1][m][n]; f32x4 o;
#pragma unroll
                    for (int j = 0; j < 4; ++j) o[j] = gt[j] * sigmoidf_(gt[j]) * up[j];
                    *(f16x4*)(rp + n * 16) = cvt4(o); } }
    }
};

__device__ __forceinline__ void attn_unit(const f16* __restrict__ Q, const f16* __restrict__ Kb, const f16* __restrict__ VT, f16* __restrict__ O, int bh, int qb, int lane) {
    const int b = bh >> 3, h = bh & 7, l32 = lane & 31, hi = lane >> 5, t0 = qb * 32, tq = t0 + l32;
    const size_t rowbase = (size_t)b * SEQ;
    f16x8 qf[4];
    { const f16* qp = Q + (rowbase + tq) * 512 + h * 64 + 8 * hi;
#pragma unroll
      for (int ks = 0; ks < 4; ++ks) qf[ks] = *(const f16x8*)(qp + 16 * ks); }
    f32x16 o0, o1;
#pragma unroll
    for (int r = 0; r < 16; ++r) { o0[r] = 0.f; o1[r] = 0.f; }
    float carry = 0.f;
    const f16* vbase = VT + (size_t)(bh * 64 + l32) * SEQ + 4 * hi;
    for (int kt = t0 >> 6; kt >= 0; --kt) {
        const int k0 = kt * 64;
        const f16* kp = Kb + (rowbase + k0 + l32) * 512 + h * 64 + 8 * hi;
        f32x16 z0, z1;
#pragma unroll
        for (int r = 0; r < 16; ++r) { z0[r] = 0.f; z1[r] = 0.f; }
#pragma unroll
        for (int ks = 0; ks < 4; ++ks) {
            const f16x8 a0 = *(const f16x8*)(kp + 16 * ks), a1 = *(const f16x8*)(kp + 32 * 512 + 16 * ks);
            z0 = __builtin_amdgcn_mfma_f32_32x32x16_f16(a0, qf[ks], z0, 0, 0, 0);
            z1 = __builtin_amdgcn_mfma_f32_32x32x16_f16(a1, qf[ks], z1, 0, 0, 0);
        }
        const bool diag = (k0 + 63 >= t0);
        f32x16 e0, e1;
#pragma unroll
        for (int r = 0; r < 16; ++r) {
            const int key = k0 + (r & 3) + 8 * (r >> 2) + 4 * hi;
            { const float z = z0[r] * 0.125f; const float sp = fmaxf(z, 0.f) + __logf(1.0f + __expf(-fabsf(z))); const bool ok = !diag || (key < tq);
              z0[r] = ok ? -sp : 0.f; e0[r] = ok ? (z - sp) : -1e30f; }
            { const float z = z1[r] * 0.125f; const float sp = fmaxf(z, 0.f) + __logf(1.0f + __expf(-fabsf(z))); const bool ok = !diag || (key + 32 < tq);
              z1[r] = ok ? -sp : 0.f; e1[r] = ok ? (z - sp) : -1e30f; }
        }
        float Gs[8], GP[8], ST[8];
#pragma unroll
        for (int g = 0; g < 4; ++g) { Gs[g] = (z0[4 * g] + z0[4 * g + 1]) + (z0[4 * g + 2] + z0[4 * g + 3]); Gs[4 + g] = (z1[4 * g] + z1[4 * g + 1]) + (z1[4 * g + 2] + z1[4 * g + 3]); }
#pragma unroll
        for (int i = 0; i < 8; ++i) GP[i] = __shfl_xor(Gs[i], 32);
        ST[7] = 0.f;
#pragma unroll
        for (int i = 6; i >= 0; --i) ST[i] = ST[i + 1] + (Gs[i + 1] + GP[i + 1]);
        const float tot = ST[0] + (Gs[0] + GP[0]);
#pragma unroll
        for (int i = 0; i < 8; ++i) {
            const float off = carry + ST[i] + (hi == 0 ? GP[i] : 0.f);
            if (i < 4) { const int r = 4 * i;
                const float a3 = off, a2 = a3 + z0[r + 3], a1 = a2 + z0[r + 2], a0 = a1 + z0[r + 1];
                e0[r] = __expf(e0[r] + a0); e0[r + 1] = __expf(e0[r + 1] + a1); e0[r + 2] = __expf(e0[r + 2] + a2); e0[r + 3] = __expf(e0[r + 3] + a3);
            } else { const int r = 4 * (i - 4);
                const float a3 = off, a2 = a3 + z1[r + 3], a1 = a2 + z1[r + 2], a0 = a1 + z1[r + 1];
                e1[r] = __expf(e1[r] + a0); e1[r + 1] = __expf(e1[r + 1] + a1); e1[r + 2] = __expf(e1[r + 2] + a2); e1[r + 3] = __expf(e1[r + 3] + a3);
            }
        }
        carry += tot;
#pragma unroll
        for (int j = 0; j < 4; ++j) {
            f16x8 wb;
#pragma unroll
            for (int i = 0; i < 8; ++i) wb[i] = (f16)((j < 2) ? e0[8 * (j & 1) + i] : e1[8 * (j & 1) + i]);
            const f16* vp = vbase + k0 + 16 * j;
            const f16x4 va0 = *(const f16x4*)(vp), va1 = *(const f16x4*)(vp + 8);
            const f16x4 vb0 = *(const f16x4*)(vp + (size_t)32 * SEQ), vb1 = *(const f16x4*)(vp + (size_t)32 * SEQ + 8);
            f16x8 fa, fb;
#pragma unroll
            for (int i = 0; i < 4; ++i) { fa[i] = va0[i]; fa[4 + i] = va1[i]; fb[i] = vb0[i]; fb[4 + i] = vb1[i]; }
            o0 = __builtin_amdgcn_mfma_f32_32x32x16_f16(fa, wb, o0, 0, 0, 0);
            o1 = __builtin_amdgcn_mfma_f32_32x32x16_f16(fb, wb, o1, 0, 0, 0);
        }
        if (__all(carry < -104.0f)) break;
    }
    f16* op = O + (rowbase + tq) * 512 + h * 64 + 4 * hi;
#pragma unroll
    for (int g = 0; g < 4; ++g) {
        f32x4 a, c;
#pragma unroll
        for (int j = 0; j < 4; ++j) { a[j] = o0[4 * g + j]; c[j] = o1[4 * g + j]; }
        *(f16x4*)(op + 8 * g) = cvt4(a); *(f16x4*)(op + 32 + 8 * g) = cvt4(c);
    }
}

__device__ __forceinline__ void row_stats(const f32x4 (&v)[4], float& mean, float& rstd) {
    float s = 0.f;
#pragma unroll
    for (int j = 0; j < 4; ++j) s += (v[j][0] + v[j][1]) + (v[j][2] + v[j][3]);
    mean = wave_sum(s) * (1.f / D);
    float q = 0.f;
#pragma unroll
    for (int j = 0; j < 4; ++j) { const f32x4 d = v[j] - mean; q += (d[0] * d[0] + d[1] * d[1]) + (d[2] * d[2] + d[3] * d[3]); }
    rstd = 1.0f / sqrtf(wave_sum(q) * (1.f / D) + LN_EPS);
}
__device__ __forceinline__ void row_mod(const float* xrow, const float* sh, const float* sc, f16* orow, int lane) {
    f32x4 v[4];
#pragma unroll
    for (int j = 0; j < 4; ++j) v[j] = *(const f32x4*)(xrow + 4 * lane + 256 * j);
    float mean, rstd; row_stats(v, mean, rstd);
#pragma unroll
    for (int j = 0; j < 4; ++j) { const int c = 4 * lane + 256 * j; const f32x4 s1 = *(const f32x4*)(sc + c) + 1.0f, s0 = *(const f32x4*)(sh + c);
        *(f16x4*)(orow + c) = cvt4((v[j] - mean) * rstd * s1 + s0); }
}
__device__ __forceinline__ void row_ln2(const float* rrow, const float* lg, const float* lb, float* xout, bool wh, const float* sh, const float* sc, f16* orow, int lane) {
    f32x4 v[4];
#pragma unroll
    for (int j = 0; j < 4; ++j) v[j] = *(const f32x4*)(rrow + 4 * lane + 256 * j);
    float mean, rstd; row_stats(v, mean, rstd);
#pragma unroll
    for (int j = 0; j < 4; ++j) { const int c = 4 * lane + 256 * j; v[j] = (v[j] - mean) * rstd * *(const f32x4*)(lg + c) + *(const f32x4*)(lb + c);
        *(f32x4*)(xout + c) = v[j]; }
    if (wh) {
        row_stats(v, mean, rstd);
#pragma unroll
        for (int j = 0; j < 4; ++j) { const int c = 4 * lane + 256 * j; const f32x4 s1 = *(const f32x4*)(sc + c) + 1.0f, s0 = *(const f32x4*)(sh + c);
            *(f16x4*)(orow + c) = cvt4((v[j] - mean) * rstd * s1 + s0); }
    }
}

__device__ __forceinline__ void transpose_item(const float* W, int K, int N, f16* WT, int mode, LAS float* scr, int item, int lane) {
    const int nblk = N / 32, kb = item / nblk, nb = item % nblk, k0 = 64 * kb, n0 = 32 * nb;
#pragma unroll 8
    for (int i = 0; i < 32; ++i) { const int kk = 2 * i + (lane >> 5); scr[kk * 33 + (lane & 31)] = W[(size_t)(k0 + kk) * N + n0 + (lane & 31)]; }
    asm volatile("s_waitcnt lgkmcnt(0)" ::: "memory");
    const int c = lane & 7;
#pragma unroll
    for (int j = 0; j < 4; ++j) { const int n = (lane >> 3) + 8 * j; const LAS float* s = scr + (8 * c) * 33 + n;
        f16x8 o;
#pragma unroll
        for (int e = 0; e < 8; ++e) o[e] = (f16)s[e * 33];
        const int nn = n0 + n; int drow = nn;
        if (mode == 1) { const int hh = nn < FH ? nn : nn - FH; drow = (hh >> 7) * 256 + (nn < FH ? 0 : 128) + (hh & 127); }
        *(f16x8*)(WT + (size_t)drow * K + k0 + 8 * c) = o; }
    asm volatile("s_waitcnt lgkmcnt(0)" ::: "memory");
}

struct Args { const float* in[24]; float* out; unsigned char* ws; };
enum { I_X = 0, I_C, I_WADA, I_BADA, I_WIN, I_WSBUP, I_ARE, I_AIM, I_LOGDT, I_BRE, I_BIM, I_CRE, I_CIM, I_DSKIP, I_WGLU, I_BGLU, I_WSSMUP, I_WOUT, I_LN1G, I_LN1B, I_WFIN, I_WFOUT, I_LN2G, I_LN2B };

template <class T> __device__ __forceinline__ T* opq(T* p) { asm volatile("" : "+s"(p)); return p; }
#define PHASE_BEGIN unsigned char* ws = opq(a.ws); float* DOUT = opq(a.out); int wv_ = wave_s; asm volatile("" : "+s"(wv_)); int tid = (wv_ << 6) | (int)__builtin_amdgcn_mbcnt_hi(~0u, __builtin_amdgcn_mbcnt_lo(~0u, 0u)); asm volatile("" : "+v"(tid)); \
    const int lane = tid & 63, wave = __builtin_amdgcn_readfirstlane(tid >> 6), gw = bid * 8 + wave, gtid = bid * 512 + tid; (void)lane; (void)wave; (void)gw; (void)gtid; (void)DOUT; (void)ws;

__global__ void __launch_bounds__(512, 2) mk_fwd(Args a) {
    extern __shared__ __attribute__((aligned(16))) unsigned char lds_raw[];
    LAS unsigned char* lds = (LAS unsigned char*)lds_raw;
    cg::grid_group grid = cg::this_grid();
    const int G = gridDim.x, bid = blockIdx.x, NGW = G * 8, NT = G * 512;
    const int wave_s = __builtin_amdgcn_readfirstlane((int)threadIdx.x >> 6);

    {
        PHASE_BEGIN
        float* mod = (float*)(ws + WS_MOD);
        LAS float* scr = (LAS float*)(lds + wave * 16384);
        constexpr int I0 = 16 * 128, I1 = 8 * 32, I2 = 8 * 16, I3 = 8 * 32, I4 = 16 * 32, I5 = 16 * 176, I6 = 44 * 32, IL = I0 + I1 + I2 + I3 + I4 + I5 + I6;
        for (int it = gw; it < 2 * IL; it += NGW) {
            const int l = it / IL; int r = it % IL; unsigned char* wl = ws + (size_t)l * WS_WL;
            if (r < I0) { transpose_item(a.in[I_WIN] + (size_t)l * D * INC, D, INC, (f16*)(wl + W_IN), 0, scr, r, lane); continue; } r -= I0;
            if (r < I1) { transpose_item(a.in[I_WSBUP] + (size_t)l * 512 * D, 512, D, (f16*)(wl + W_SBUP), 0, scr, r, lane); continue; } r -= I1;
            if (r < I2) { transpose_item(a.in[I_WGLU] + (size_t)l * 512 * 512, 512, 512, (f16*)(wl + W_GLU), 0, scr, r, lane); continue; } r -= I2;
            if (r < I3) { transpose_item(a.in[I_WSSMUP] + (size_t)l * 512 * D, 512, D, (f16*)(wl + W_SSMUP), 0, scr, r, lane); continue; } r -= I3;
            if (r < I4) { transpose_item(a.in[I_WOUT] + (size_t)l * D * D, D, D, (f16*)(wl + W_OUT), 0, scr, r, lane); continue; } r -= I4;
            if (r < I5) { transpose_item(a.in[I_WFIN] + (size_t)l * D * 2 * FH, D, 2 * FH, (f16*)(wl + W_FIN), 1, scr, r, lane); continue; } r -= I5;
            transpose_item(a.in[I_WFOUT] + (size_t)l * FH * D, FH, D, (f16*)(wl + W_FOUT), 0, scr, r, lane);
        }
        for (int it = gw; it < 1536; it += NGW) {
            const int l = it / 768, r = it % 768, jb = r >> 3, kc = r & 7, j = jb * 64 + lane;
            const float* w = a.in[I_WADA] + (size_t)l * D * NMOD + (size_t)(kc * 128) * NMOD + j;
            const float* cc = a.in[I_C] + kc * 128;
            float a0 = 0.f, a1 = 0.f, a2 = 0.f, a3 = 0.f;
            for (int k = 0; k < 128; ++k) {
                const float wv = w[(size_t)k * NMOD];
                const float c0 = cc[k], c1 = cc[D + k], c2 = cc[2 * D + k], c3 = cc[3 * D + k];
                a0 += c0 * sigmoidf_(c0) * wv; a1 += c1 * sigmoidf_(c1) * wv; a2 += c2 * sigmoidf_(c2) * wv; a3 += c3 * sigmoidf_(c3) * wv;
            }
            if (kc == 0) { const float bv = a.in[I_BADA][l * NMOD + j]; a0 += bv; a1 += bv; a2 += bv; a3 += bv; }
            atomicAdd(mod + (size_t)(l * 4 + 0) * NMOD + j, a0); atomicAdd(mod + (size_t)(l * 4 + 1) * NMOD + j, a1);
            atomicAdd(mod + (size_t)(l * 4 + 2) * NMOD + j, a2); atomicAdd(mod + (size_t)(l * 4 + 3) * NMOD + j, a3);
        }
        for (int e = gtid; e < 2 * 32 * 65536; e += NT) {
            const int col = e & 255, row = (e >> 8) & 255, lg = e >> 16;
            float val = 0.f;
            if (row < 128) {
                const int p = row & 63, isim = row >> 6, j = col >> 4, ci = col & 15;
                const float are = a.in[I_ARE][lg * 64 + p], aim = a.in[I_AIM][lg * 64 + p], dt = expf(a.in[I_LOGDT][lg]);
                float lr, li; cexp_k(are * dt, aim * dt, 1.0f, lr, li);
                const float nr = lr - 1.0f, ni = li, den = 1.0f / (are * are + aim * aim);
                const float cr = (nr * are + ni * aim) * den, ci_ = (ni * are - nr * aim) * den;
                float pr, pi; cexp_k(are * dt, aim * dt, (float)(15 - j), pr, pi);
                const float qr = pr * cr - pi * ci_, qi = pr * ci_ + pi * cr;
                const float br = a.in[I_BRE][(size_t)(lg * 64 + p) * 16 + ci], bi = a.in[I_BIM][(size_t)(lg * 64 + p) * 16 + ci];
                val = isim ? (qr * bi + qi * br) : (qr * br - qi * bi);
            }
            const int l = lg >> 5, g = lg & 31;
            ((f16*)(ws + WS_SSM + (size_t)l * WS_SSML + S_W1))[((size_t)(g * 256 + row)) * 256 + col] = (f16)val;
        }
        for (int e = gtid; e < 2 * 32 * 32768; e += NT) {
            const int c2 = e & 127, row = (e >> 7) & 255, lg = e >> 15;
            const int p = c2 & 63, isim = c2 >> 6, i = row >> 4, co = row & 15;
            const float are = a.in[I_ARE][lg * 64 + p], aim = a.in[I_AIM][lg * 64 + p], dt = expf(a.in[I_LOGDT][lg]);
            float pr, pi; cexp_k(are * dt, aim * dt, (float)(i + 1), pr, pi);
            const float cr = a.in[I_CRE][(size_t)(lg * 16 + co) * 64 + p], ci_ = a.in[I_CIM][(size_t)(lg * 16 + co) * 64 + p];
            const float val = isim ? -(cr * pi + ci_ * pr) : (cr * pr - ci_ * pi);
            const int l = lg >> 5, g = lg & 31;
            ((f16*)(ws + WS_SSM + (size_t)l * WS_SSML + S_TW))[((size_t)(g * 256 + row)) * 384 + 256 + c2] = (f16)val;
        }
        for (int e = gtid; e < 2 * 32 * 16 * 16; e += NT) {
            const int co = e & 15, d = (e >> 4) & 15, lg = e >> 8;
            const float dt = expf(a.in[I_LOGDT][lg]);
            float accv[16];
#pragma unroll
            for (int ci = 0; ci < 16; ++ci) accv[ci] = 0.f;
            for (int p = 0; p < 64; ++p) {
                const float are = a.in[I_ARE][lg * 64 + p], aim = a.in[I_AIM][lg * 64 + p];
                float lr, li; cexp_k(are * dt, aim * dt, 1.0f, lr, li);
                const float nr = lr - 1.0f, ni = li, den = 1.0f / (are * are + aim * aim);
                const float cr = (nr * are + ni * aim) * den, ci_ = (ni * are - nr * aim) * den;
                float pr, pi; cexp_k(are * dt, aim * dt, (float)d, pr, pi);
                const float qr = pr * cr - pi * ci_, qi = pr * ci_ + pi * cr;
                const float c_r = a.in[I_CRE][(size_t)(lg * 16 + co) * 64 + p], c_i = a.in[I_CIM][(size_t)(lg * 16 + co) * 64 + p];
                const float er = c_r * qr - c_i * qi, ei = c_r * qi + c_i * qr;
                const float* brp = a.in[I_BRE] + (size_t)(lg * 64 + p) * 16; const float* bip = a.in[I_BIM] + (size_t)(lg * 64 + p) * 16;
#pragma unroll
                for (int ci = 0; ci < 16; ++ci) accv[ci] += er * brp[ci] - ei * bip[ci];
            }
            const int l = lg >> 5, g = lg & 31;
            float* kd = (float*)(ws + WS_SSM + (size_t)l * WS_SSML + S_KD) + ((size_t)((g * 16 + d) * 16 + co)) * 16;
#pragma unroll
            for (int ci = 0; ci < 16; ++ci) kd[ci] = accv[ci];
        }
    }
    grid.sync();
    {
        PHASE_BEGIN
        const float* mod = (const float*)(ws + WS_MOD); f16* XN = (f16*)(ws + WS_XN);
        for (int m = gw; m < M; m += NGW) { const int b = m >> 13; const float* mb = mod + (size_t)b * NMOD;
            row_mod(a.in[I_X] + (size_t)m * D, mb, mb + D, XN + (size_t)m * D, lane); }
        for (int e = gtid; e < 2 * 32 * 65536; e += NT) {
            const int col = e & 255, row = (e >> 8) & 255, lg = e >> 16, l = lg >> 5, g = lg & 31;
            const int i = row >> 4, co = row & 15, j = col >> 4, ci = col & 15;
            float val = 0.f;
            if (j <= i) val = ((const float*)(ws + WS_SSM + (size_t)l * WS_SSML + S_KD))[((size_t)((g * 16 + (i - j)) * 16 + co)) * 16 + ci];
            ((f16*)(ws + WS_SSM + (size_t)l * WS_SSML + S_TW))[((size_t)(g * 256 + row)) * 384 + col] = (f16)val;
        }
    }
    grid.sync();

#pragma unroll 1
    for (int l = 0; l < 2; ++l) {
        { PHASE_BEGIN
          pg8::Gemm g{(const f16*)(ws + WS_XN), (const f16*)(ws + (size_t)l * WS_WL + W_IN), D, D, D}; pg8::StaticOrder S; S.init(M, INC, G, bid);
          EpiInProj E{(f16*)(ws + WS_Q), (f16*)(ws + WS_K), (f16*)(ws + WS_VT), (f16*)(ws + WS_UG), (f16*)(ws + WS_SG)};
          pg8::gemm_phase<EpiInProj, pg8::StaticOrder, true>(lds, g, S, E, wave); }
        grid.sync();
        { PHASE_BEGIN
          for (int u = gw; u < 8192; u += NGW) attn_unit((const f16*)(ws + WS_Q), (const f16*)(ws + WS_K), (const f16*)(ws + WS_VT), (f16*)(ws + WS_O), u >> 8, u & 255, lane); }
        __syncthreads();
        { PHASE_BEGIN
          pg8::Gemm g{(const f16*)(ws + WS_UG), (const f16*)(ws + WS_SSM + (size_t)l * WS_SSML + S_W1), 256, 384, 256}; pg8::GroupOrder S{G, bid};
          EpiSsm1 E{(float*)(ws + WS_S)};
          pg8::gemm_phase<EpiSsm1, pg8::GroupOrder, false>(lds, g, S, E, wave); }
        grid.sync();
        { PHASE_BEGIN
          if (wave == 0 && bid < 128) {
            const float* Sb = (const float*)(ws + WS_S); f16* Ug = (f16*)(ws + WS_UG);
            const int b = bid >> 5, g = bid & 31, lg = l * 32 + g, p = lane;
            const float are = a.in[I_ARE][lg * 64 + p], aim = a.in[I_AIM][lg * 64 + p], dt = expf(a.in[I_LOGDT][lg]);
            float ar, ai; cexp_k(are * dt, aim * dt, 16.0f, ar, ai);
            float sr = 0.f, si = 0.f;
            const size_t row0 = (size_t)g * 2048 + (size_t)b * 512;
            for (int c0 = 0; c0 < 512; c0 += 8) {
                float vr[8], vi[8];
#pragma unroll
                for (int q = 0; q < 8; ++q) { const float* sp = Sb + (row0 + c0 + q) * 128 + p; vr[q] = sp[0]; vi[q] = sp[64]; }
#pragma unroll
                for (int q = 0; q < 8; ++q) {
                    f16* up = Ug + (row0 + c0 + q) * 384 + 256 + p; up[0] = (f16)sr; up[64] = (f16)si;
                    const float nr = ar * sr - ai * si + vr[q], ni = ar * si + ai * sr + vi[q]; sr = nr; si = ni;
                }
            }
          } }
        grid.sync();
        { PHASE_BEGIN
          pg8::Gemm g{(const f16*)(ws + WS_UG), (const f16*)(ws + WS_SSM + (size_t)l * WS_SSML + S_TW), 384, 384, 384}; pg8::GroupOrder S{G, bid};
          EpiSsm3 E{(const f16*)(ws + WS_UG), a.in[I_DSKIP] + l * 512, (f16*)(ws + WS_YS)};
          pg8::gemm_phase<EpiSsm3, pg8::GroupOrder, false>(lds, g, S, E, wave); }
        grid.sync();
        { PHASE_BEGIN
          pg8::Gemm g{(const f16*)(ws + WS_YS), (const f16*)(ws + (size_t)l * WS_WL + W_GLU), 512, 512, 512}; pg8::StaticOrder S; S.init(M, 512, G, bid);
          EpiGlu E{(const f16*)(ws + WS_YS), a.in[I_BGLU] + l * 512, (f16*)(ws + WS_S5)};
          pg8::gemm_phase<EpiGlu, pg8::StaticOrder, true>(lds, g, S, E, wave); }
        { PHASE_BEGIN
          pg8::Gemm g{(const f16*)(ws + WS_O), (const f16*)(ws + (size_t)l * WS_WL + W_SBUP), 512, 512, 512}; pg8::StaticOrder S; S.init(M, D, G, bid);
          EpiUp<false> E{(const f16*)(ws + WS_SG), 0, nullptr, (f16*)(ws + WS_TMP)};
          pg8::gemm_phase<EpiUp<false>, pg8::StaticOrder, true>(lds, g, S, E, wave); }
        grid.sync();
        { PHASE_BEGIN
          pg8::Gemm g{(const f16*)(ws + WS_S5), (const f16*)(ws + (size_t)l * WS_WL + W_SSMUP), 512, 512, 512}; pg8::StaticOrder S; S.init(M, D, G, bid);
          EpiUp<true> E{(const f16*)(ws + WS_SG), 1024, (const f16*)(ws + WS_TMP), (f16*)(ws + WS_MRG)};
          pg8::gemm_phase<EpiUp<true>, pg8::StaticOrder, true>(lds, g, S, E, wave); }
        grid.sync();
        { PHASE_BEGIN
          pg8::Gemm g{(const f16*)(ws + WS_MRG), (const f16*)(ws + (size_t)l * WS_WL + W_OUT), D, D, D}; pg8::StaticOrder S; S.init(M, D, G, bid);
          EpiRes E{l == 0 ? a.in[I_X] : (const float*)DOUT, (const float*)(ws + WS_MOD) + (size_t)l * 4 * NMOD + 2 * D, DOUT};
          pg8::gemm_phase<EpiRes, pg8::StaticOrder, true>(lds, g, S, E, wave); }
        grid.sync();
        { PHASE_BEGIN
          const float* modl = (const float*)(ws + WS_MOD) + (size_t)l * 4 * NMOD; f16* XN = (f16*)(ws + WS_XN);
          for (int m = gw; m < M; m += NGW) { const int b = m >> 13; const float* mb = modl + (size_t)b * NMOD;
            row_ln2(DOUT + (size_t)m * D, a.in[I_LN1G] + l * D, a.in[I_LN1B] + l * D, DOUT + (size_t)m * D, true, mb + 3 * D, mb + 4 * D, XN + (size_t)m * D, lane); } }
        grid.sync();
        { PHASE_BEGIN
          pg8::Gemm g{(const f16*)(ws + WS_XN), (const f16*)(ws + (size_t)l * WS_WL + W_FIN), D, D, D}; pg8::StaticOrder S; S.init(M, 2 * FH, G, bid);
          EpiFfnIn E{(f16*)(ws + WS_H)};
          pg8::gemm_phase<EpiFfnIn, pg8::StaticOrder, true>(lds, g, S, E, wave); }
        grid.sync();
        { PHASE_BEGIN
          pg8::Gemm g{(const f16*)(ws + WS_H), (const f16*)(ws + (size_t)l * WS_WL + W_FOUT), FH, FH, FH}; pg8::StaticOrder S; S.init(M, D, G, bid);
          EpiRes E{DOUT, (const float*)(ws + WS_MOD) + (size_t)l * 4 * NMOD + 5 * D, (float*)(ws + WS_R2)};
          pg8::gemm_phase<EpiRes, pg8::StaticOrder, true>(lds, g, S, E, wave); }
        grid.sync();
        { PHASE_BEGIN
          const float* modn = (const float*)(ws + WS_MOD) + (size_t)4 * NMOD; f16* XN = (f16*)(ws + WS_XN); const float* R2 = (const float*)(ws + WS_R2);
          for (int m = gw; m < M; m += NGW) { const int b = m >> 13; const float* mb = modn + (size_t)b * NMOD;
            row_ln2(R2 + (size_t)m * D, a.in[I_LN2G] + l * D, a.in[I_LN2B] + l * D, DOUT + (size_t)m * D, l == 0, mb, mb + D, XN + (size_t)m * D, lane); } }
        if (l == 0) grid.sync();
    }
}

extern "C" void kernel_launch(void* const* d_in, const int* in_sizes, int n_in, void* d_out, int out_size, void* d_ws, size_t ws_size, hipStream_t stream) {
    static int grid = 0;
    if (grid == 0) {
        if (n_in != 24 || in_sizes[0] != M * D || out_size != M * D || ws_size < WS_NEED) { fprintf(stderr, "kernel_launch: unexpected shapes (n_in %d, in0 %d, out %d, ws %zu)\n", n_in, n_in > 0 ? in_sizes[0] : -1, out_size, ws_size); grid = -1; return; }
        int dev = 0, cus = 0, per_cu = 0;
        if (hipGetDevice(&dev) != hipSuccess || hipDeviceGetAttribute(&cus, hipDeviceAttributeMultiprocessorCount, dev) != hipSuccess) { grid = -1; return; }
        if (hipFuncSetAttribute((const void*)mk_fwd, hipFuncAttributeMaxDynamicSharedMemorySize, LDS_BYTES) != hipSuccess) { fprintf(stderr, "kernel_launch: hipFuncSetAttribute failed\n"); grid = -1; return; }
        if (hipOccupancyMaxActiveBlocksPerMultiprocessor(&per_cu, (const void*)mk_fwd, 512, LDS_BYTES) != hipSuccess || per_cu < 1) { fprintf(stderr, "kernel_launch: occupancy query says %d blocks per CU\n", per_cu); per_cu = 1; }
        (void)hipGetLastError();
        grid = cus * 1;
    }
    if (grid < 0) return;
    (void)hipMemsetAsync((char*)d_ws + WS_MOD, 0, MOD_BYTES, stream);
    Args a{};
    for (int i = 0; i < 24; ++i) a.in[i] = (const float*)d_in[i];
    a.out = (float*)d_out; a.ws = (unsigned char*)d_ws;
    void* args[] = {&a};
    hipError_t e = hipLaunchCooperativeKernel((const void*)mk_fwd, dim3(grid), dim3(512), args, LDS_BYTES, stream);
    if (e != hipSuccess) fprintf(stderr, "cooperative launch failed: %s (grid %d)\n", hipGetErrorString(e), grid);
}
```

```cpp
#include <hip/hip_runtime.h>
#include <hip/hip_cooperative_groups.h>
#include <cstdio>
#include <cstdint>
namespace cg = cooperative_groups;

#define LAS __attribute__((address_space(3)))
typedef _Float16 f16;
typedef _Float16 f16x8 __attribute__((ext_vector_type(8)));
typedef _Float16 f16x4 __attribute__((ext_vector_type(4)));
typedef float f32x4 __attribute__((ext_vector_type(4)));
typedef float f32x16 __attribute__((ext_vector_type(16)));

constexpr int D = 1024, NB = 4, SEQ = 8192, M = NB * SEQ, NMOD = 6 * D;
constexpr int INC = 4096, FH = 2816;
constexpr float ALPHA = 1.41421356237309515f;
constexpr float LN_EPS = 1e-5f;
constexpr size_t MiB = 1u << 20;
constexpr size_t WS_WL = 29 * MiB;
constexpr size_t W_IN = 0, W_SBUP = 8 * MiB, W_GLU = 9 * MiB, W_SSMUP = 9 * MiB + MiB / 2, W_OUT = 10 * MiB + MiB / 2, W_FIN = 12 * MiB + MiB / 2, W_FOUT = 23 * MiB + MiB / 2;
constexpr size_t WS_SSM = 58 * MiB, WS_SSML = 10 * MiB + MiB / 2;
constexpr size_t S_TW = 0, S_W1 = 6 * MiB, S_KD = 10 * MiB;
constexpr size_t WS_MOD = 79 * MiB;
constexpr size_t MOD_BYTES = 2 * 4 * 6144 * 4;
constexpr size_t WS_BAR = WS_MOD + 256 * 1024, ZERO_BYTES = 256 * 1024 + 16 * 1024;
constexpr size_t WS_XN = 80 * MiB;
constexpr size_t WS_Q = 144 * MiB, WS_K = 176 * MiB, WS_VT = 208 * MiB, WS_UG = 240 * MiB, WS_SG = 288 * MiB, WS_O = 416 * MiB, WS_S = 448 * MiB, WS_YS = 480 * MiB;
constexpr size_t WS_S5 = WS_Q, WS_TMP = WS_K, WS_MRG = WS_O;
constexpr size_t WS_H = 144 * MiB, WS_R2 = 320 * MiB;
constexpr size_t WS_NEED = 512 * MiB;
constexpr int LDS_BYTES = 147456;
#define REP_ATTN 1
#define REP_SCAN 1
#define REP_TABLES 1
#define REP_ROW 1
#define REP_SYNC 1
#define GSYNC() do { XcdBarrier xb_; xb_.bar = (unsigned*)(opq(a.ws) + WS_BAR); { unsigned x_ = xcc_s; asm volatile("" : "+s"(x_)); xb_.x = x_; } xb_.st = (volatile LAS unsigned*)(lds + 131072); xcd_barrier(xb_, is_t0()); } while (0)

namespace pg8 {
constexpr int BM = 256, BK = 64, HALF = 128, HTB = HALF * BK * 2, NXCD = 8, WGM = 8;
__host__ __device__ __forceinline__ int lds_byte(int r, int c) { const int st = (r >> 4) * 2 + (c >> 5), rr = r & 15, cc = c & 31, ob = rr * 64 + cc * 2; return st * 1024 + (ob ^ (((ob >> 9) & 1) << 5)); }
__host__ __device__ __forceinline__ void stage_rc(int b, int& R, int& C) { const int st = b / 1024, sb = b % 1024, swz = sb ^ (((sb >> 9) & 1) << 5); R = (st >> 1) * 16 + swz / 64; C = (st & 1) * 32 + (swz % 64) / 2; }

struct Unit { int pm, pn; };
struct Gemm { const f16* A; const f16* Bt; int K, lda, ldb; };

struct StaticOrder {
    int nM, nN, nwg, G, c;
    __device__ void init(int M_, int N_, int G_, int c_) { nM = M_ / BM; nN = N_ / BM; nwg = nM * nN; G = G_; c = c_; }
    __device__ bool next(int i, Unit& u) const {
        const long L = (long)i * G + c; if (L >= nwg) return false;
        int wgid = (int)L; { const int q = nwg / NXCD, r = nwg % NXCD, xcd = wgid % NXCD, off = wgid / NXCD; wgid = (xcd < r ? xcd * (q + 1) : r * (q + 1) + (xcd - r) * q) + off; }
        const int nig = WGM * nN, gid = wgid / nig, fm = gid * WGM, gsz = (nM - fm) < WGM ? (nM - fm) : WGM;
        u.pm = fm + ((wgid % nig) % gsz); u.pn = (wgid % nig) / gsz; return true;
    }
};
struct GroupOrder {
    int G, c;
    __device__ bool next(int i, Unit& u) const { const int L = i * G + c; if (L >= 256) return false; u.pm = L; u.pn = L >> 3; return true; }
};

template <class Epi, class Sched, bool ALIGN_EPI>
__device__ __forceinline__ void gemm_phase(LAS unsigned char* lds, const Gemm g, const Sched& S, const Epi& E, int wid_in) {
    int tid = (wid_in << 6) | (int)__builtin_amdgcn_mbcnt_hi(~0u, __builtin_amdgcn_mbcnt_lo(~0u, 0u)); asm volatile("" : "+v"(tid));
    const int wid = __builtin_amdgcn_readfirstlane(tid >> 6), lane = tid & 63, wr = wid >> 2, wc = wid & 3, fr = lane & 15, fq = lane >> 4;
    const int K = g.K, nt = K / BK;
    unsigned voffA[2], voffB[2];
#pragma unroll
    for (int i = 0; i < 2; ++i) { int R, C; stage_rc(tid * 16 + i * 8192, R, C);
        voffA[i] = (unsigned)(R * g.lda + C) * 2u; voffB[i] = (unsigned)(R * g.ldb + C) * 2u; }
    const size_t kstep = (size_t)(BK * 2);
    const size_t hstepA = (size_t)HALF * g.lda * 2, hstepB = (size_t)HALF * g.ldb * 2;
    const size_t tstepA = 2 * hstepA, tstepB = 2 * hstepB;
    const unsigned ldsw = (unsigned)wid * 1024u;
    const int aoff = lds_byte(wr * 64 + fr, fq * 8), boff = lds_byte(wc * 32 + fr, fq * 8);
#define PG8_SA(b, h) (((b) * 2 + (h)) * HTB)
#define PG8_SB(b, h) ((4 + (b) * 2 + (h)) * HTB)
#define PG8_STAGE(bufoff, gbase, voff) do { _Pragma("unroll") for (int _i = 0; _i < 2; ++_i) \
        __builtin_amdgcn_global_load_lds((const unsigned*)((const char*)(gbase) + (voff)[_i]), (LAS unsigned*)(lds + (bufoff) + ldsw + _i * 8192), 16, 0, 0); } while (0)
#define PG8_LDA(dst, b, h) do { _Pragma("unroll") for (int m = 0; m < 4; ++m) _Pragma("unroll") for (int k = 0; k < 2; ++k) dst[m][k] = *(const LAS f16x8*)(lds + PG8_SA(b, h) + aoff + m * 2048 + k * 1024); } while (0)
#define PG8_LDB(dst, b, h) do { _Pragma("unroll") for (int n = 0; n < 2; ++n) _Pragma("unroll") for (int k = 0; k < 2; ++k) dst[n][k] = *(const LAS f16x8*)(lds + PG8_SB(b, h) + boff + n * 2048 + k * 1024); } while (0)
#define PG8_MMA(ai, bj, At, Bt) do { __builtin_amdgcn_s_setprio(1); _Pragma("unroll") for (int m = 0; m < 4; ++m) _Pragma("unroll") for (int n = 0; n < 2; ++n) _Pragma("unroll") for (int k = 0; k < 2; ++k) \
        acc[ai][bj][m][n] = __builtin_amdgcn_mfma_f32_16x16x32_f16(Bt[n][k], At[m][k], acc[ai][bj][m][n], 0, 0, 0); __builtin_amdgcn_s_setprio(0); } while (0)
#define PG8_WAIT_V(n) asm volatile("s_waitcnt vmcnt(" #n ")" ::: "memory")
#define PG8_WAIT_L(n) asm volatile("s_waitcnt lgkmcnt(" #n ")" ::: "memory")
#define PG8_BAR __builtin_amdgcn_s_barrier()
#define PG8_SCHED __builtin_amdgcn_sched_barrier(0)
    Unit cur, nxt; int ui = 0;
    if (!S.next(0, cur)) return;
    f32x4 acc[2][2][4][2];
#pragma unroll
    for (int a = 0; a < 2; ++a)
#pragma unroll
        for (int b = 0; b < 2; ++b)
#pragma unroll
            for (int m = 0; m < 4; ++m)
#pragma unroll
                for (int n = 0; n < 2; ++n) acc[a][b][m][n] = (f32x4){0.f, 0.f, 0.f, 0.f};
    f16x8 At[4][2], B0[2][2], B1[2][2];
    const char* cA = (const char*)g.A + (size_t)cur.pm * tstepA; const char* cB = (const char*)g.Bt + (size_t)cur.pn * tstepB;
    PG8_STAGE(PG8_SB(0, 0), cB, voffB); PG8_STAGE(PG8_SB(0, 1), cB + hstepB, voffB); PG8_STAGE(PG8_SA(0, 0), cA, voffA); PG8_STAGE(PG8_SA(0, 1), cA + hstepA, voffA);
    if (wr == 1) PG8_BAR;
    PG8_WAIT_V(2); PG8_BAR;
    PG8_STAGE(PG8_SB(1, 0), cB + kstep, voffB); PG8_STAGE(PG8_SA(1, 0), cA + kstep, voffA); PG8_STAGE(PG8_SB(1, 1), cB + hstepB + kstep, voffB);
    PG8_WAIT_V(6); PG8_BAR;
    for (;;) {
        const bool has_next = S.next(ui + 1, nxt);
        const char* nA = has_next ? (const char*)g.A + (size_t)nxt.pm * tstepA : cA; const char* nB = has_next ? (const char*)g.Bt + (size_t)nxt.pn * tstepB : cB;
        for (int t = 0; t < nt; t += 2) {
            const bool last = (t == nt - 2);
            const char* a1 = cA + (size_t)(t + 1) * kstep;
            const char* a2 = last ? nA : cA + (size_t)(t + 2) * kstep; const char* b2 = last ? nB : cB + (size_t)(t + 2) * kstep;
            const char* a3 = a2 + kstep; const char* b3 = b2 + kstep;
            PG8_LDB(B0, 0, 0); PG8_LDB(B1, 0, 1); PG8_SCHED; PG8_LDA(At, 0, 0); PG8_STAGE(PG8_SA(1, 1), a1 + hstepA, voffA);
            PG8_WAIT_V(8); PG8_WAIT_L(0); PG8_BAR; PG8_MMA(0, 0, At, B0); PG8_MMA(0, 1, At, B1); PG8_BAR; PG8_SCHED;
            PG8_LDA(At, 0, 1); PG8_STAGE(PG8_SB(0, 0), b2, voffB); PG8_STAGE(PG8_SB(0, 1), b2 + hstepB, voffB); PG8_STAGE(PG8_SA(0, 0), a2, voffA);
            PG8_WAIT_V(8); PG8_WAIT_L(0); PG8_BAR; PG8_MMA(1, 0, At, B0); PG8_MMA(1, 1, At, B1); PG8_BAR; PG8_SCHED;
            PG8_LDB(B0, 1, 0); PG8_LDB(B1, 1, 1); PG8_SCHED; PG8_LDA(At, 1, 0); PG8_STAGE(PG8_SA(0, 1), a2 + hstepA, voffA);
            PG8_WAIT_V(8); PG8_WAIT_L(0); PG8_BAR; PG8_MMA(0, 0, At, B0); PG8_MMA(0, 1, At, B1); PG8_BAR; PG8_SCHED;
            PG8_LDA(At, 1, 1); PG8_STAGE(PG8_SB(1, 0), b3, voffB); PG8_STAGE(PG8_SB(1, 1), b3 + hstepB, voffB); PG8_STAGE(PG8_SA(1, 0), a3, voffA);
            PG8_WAIT_V(8); PG8_WAIT_L(0); PG8_BAR; PG8_MMA(1, 0, At, B0); PG8_MMA(1, 1, At, B1); PG8_BAR; PG8_SCHED;
        }
        if constexpr (ALIGN_EPI) { if (wr == 0) PG8_BAR; }
        { int l2 = (int)__builtin_amdgcn_mbcnt_hi(~0u, __builtin_amdgcn_mbcnt_lo(~0u, 0u)); asm volatile("" : "+v"(l2));
          E(acc, cur, wr, wc, l2 & 15, l2 >> 4); }
        if (!has_next) break;
#pragma unroll
        for (int a = 0; a < 2; ++a)
#pragma unroll
            for (int b = 0; b < 2; ++b)
#pragma unroll
                for (int m = 0; m < 4; ++m)
#pragma unroll
                    for (int n = 0; n < 2; ++n) acc[a][b][m][n] = (f32x4){0.f, 0.f, 0.f, 0.f};
        cur = nxt; cA = nA; cB = nB; ++ui;
        if constexpr (ALIGN_EPI) { if (wr == 1) PG8_BAR; }
    }
    PG8_WAIT_V(0);
    if constexpr (!ALIGN_EPI) { if (wr == 0) PG8_BAR; }
    PG8_BAR;
#undef PG8_SA
#undef PG8_SB
#undef PG8_STAGE
#undef PG8_LDA
#undef PG8_LDB
#undef PG8_MMA
#undef PG8_WAIT_V
#undef PG8_WAIT_L
#undef PG8_BAR
#undef PG8_SCHED
}
}
using pg8::Unit;
typedef const f32x4 (&AccRef)[2][2][4][2];

__device__ __forceinline__ float sigmoidf_(float x) { return 1.0f / (1.0f + __expf(-x)); }
__device__ __forceinline__ float gelu_tanh(float y) { const float t = 0.7978845608028654f * (y + 0.044715f * y * y * y); const float e = __expf(2.0f * t); const float th = 1.0f - 2.0f / (e + 1.0f); return 0.5f * y * (1.0f + th); }
__device__ __forceinline__ f16x4 cvt4(f32x4 v) { f16x4 o; o[0] = (f16)v[0]; o[1] = (f16)v[1]; o[2] = (f16)v[2]; o[3] = (f16)v[3]; return o; }
__device__ __forceinline__ float wave_sum(float v) {
#pragma unroll
    for (int o = 1; o < 64; o <<= 1) v += __shfl_xor(v, o);
    return v;
}
__device__ __forceinline__ void cexp_k(float re, float im, float k, float& er, float& ei) {
    const float mag = expf(k * re);
    float turns = k * im * 0.15915494309189535f; turns -= rintf(turns);
    const float ang = turns * 6.283185307179586f;
    er = mag * cosf(ang); ei = mag * sinf(ang);
}

struct EpiInProj {
    f16* Q; f16* Kb; f16* VT; f16* Ug; f16* SG;
    __device__ __forceinline__ void operator()(AccRef acc, const Unit& u, int wr, int wc, int fr, int fq) const {
        const int pn = u.pn, row0 = u.pm * 256 + wr * 64 + fr, cl0 = wc * 32 + 4 * fq;
        if (pn < 4) {
            f16* base = (pn < 2 ? Q : Kb) + (pn & 1) * 256 + cl0;
#pragma unroll
            for (int ai = 0; ai < 2; ++ai)
#pragma unroll
                for (int m = 0; m < 4; ++m) { f16* rp = base + (size_t)(row0 + ai * 128 + m * 16) * 512;
#pragma unroll
                    for (int bj = 0; bj < 2; ++bj)
#pragma unroll
                        for (int n = 0; n < 2; ++n) *(f16x4*)(rp + bj * 128 + n * 16) = cvt4(acc[ai][bj][m][n]); }
        } else if (pn < 6) {
#pragma unroll
            for (int ai = 0; ai < 2; ++ai)
#pragma unroll
                for (int m = 0; m < 4; ++m) { const int row = row0 + ai * 128 + m * 16, b = row >> 13, s = row & 8191;
#pragma unroll
                    for (int bj = 0; bj < 2; ++bj)
#pragma unroll
                        for (int n = 0; n < 2; ++n) { const int col = (pn - 4) * 256 + bj * 128 + n * 16 + cl0;
#pragma unroll
                            for (int j = 0; j < 4; ++j) VT[(size_t)(b * 512 + col + j) * 8192 + s] = (f16)acc[ai][bj][m][n][j]; } }
        } else if (pn < 8) {
#pragma unroll
            for (int ai = 0; ai < 2; ++ai)
#pragma unroll
                for (int m = 0; m < 4; ++m) { const int chunk = u.pm * 16 + ai * 8 + wr * 4 + m;
#pragma unroll
                    for (int bj = 0; bj < 2; ++bj)
#pragma unroll
                        for (int n = 0; n < 2; ++n) { const int g = (pn - 6) * 16 + bj * 8 + wc * 2 + n;
                            *(f16x4*)(Ug + (size_t)(g * 2048 + chunk) * 384 + fr * 16 + 4 * fq) = cvt4(acc[ai][bj][m][n]); } }
        } else {
            f16* base = SG + (pn - 8) * 256 + cl0;
#pragma unroll
            for (int ai = 0; ai < 2; ++ai)
#pragma unroll
                for (int m = 0; m < 4; ++m) { f16* rp = base + (size_t)(row0 + ai * 128 + m * 16) * 2048;
#pragma unroll
                    for (int bj = 0; bj < 2; ++bj)
#pragma unroll
                        for (int n = 0; n < 2; ++n) { const f32x4 v = acc[ai][bj][m][n]; f32x4 s; s[0] = sigmoidf_(v[0]); s[1] = sigmoidf_(v[1]); s[2] = sigmoidf_(v[2]); s[3] = sigmoidf_(v[3]);
                            *(f16x4*)(rp + bj * 128 + n * 16) = cvt4(s); } }
        }
    }
};
struct EpiSsm1 {
    float* S;
    __device__ __forceinline__ void operator()(AccRef acc, const Unit& u, int wr, int wc, int fr, int fq) const {
        const int row0 = u.pm * 256 + wr * 64 + fr;
#pragma unroll
        for (int ai = 0; ai < 2; ++ai)
#pragma unroll
            for (int m = 0; m < 4; ++m) { float* rp = S + (size_t)(row0 + ai * 128 + m * 16) * 128 + wc * 32 + 4 * fq;
#pragma unroll
                for (int n = 0; n < 2; ++n) *(f32x4*)(rp + n * 16) = acc[ai][0][m][n]; }
    }
};
struct EpiSsm3 {
    const f16* Ug; const float* dskip; f16* YS;
    __device__ __forceinline__ void operator()(AccRef acc, const Unit& u, int wr, int wc, int fr, int fq) const {
        const int g = u.pn, trow0 = u.pm * 256 + wr * 64 + fr;
        const f32x4 dv = *(const f32x4*)(dskip + 16 * g + 4 * fq);
#pragma unroll
        for (int ai = 0; ai < 2; ++ai)
#pragma unroll
            for (int m = 0; m < 4; ++m) { const int trow = trow0 + ai * 128 + m * 16, chunk = trow - g * 2048;
#pragma unroll
                for (int bj = 0; bj < 2; ++bj)
#pragma unroll
                    for (int n = 0; n < 2; ++n) { const int i = bj * 8 + wc * 2 + n;
                        const f16x4 uv = *(const f16x4*)(Ug + (size_t)trow * 384 + i * 16 + 4 * fq);
                        const f32x4 a = acc[ai][bj][m][n]; f32x4 y;
#pragma unroll
                        for (int j = 0; j < 4; ++j) y[j] = gelu_tanh(a[j] + dv[j] * (float)uv[j]);
                        *(f16x4*)(YS + (size_t)(chunk * 16 + i) * 512 + 16 * g + 4 * fq) = cvt4(y); } }
    }
};
struct EpiGlu {
    const f16* YS; const float* bias; f16* S5;
    __device__ __forceinline__ void operator()(AccRef acc, const Unit& u, int wr, int wc, int fr, int fq) const {
        const int row0 = u.pm * 256 + wr * 64 + fr, col0 = u.pn * 256 + wc * 32 + 4 * fq;
#pragma unroll
        for (int ai = 0; ai < 2; ++ai)
#pragma unroll
            for (int m = 0; m < 4; ++m) { const size_t ro = (size_t)(row0 + ai * 128 + m * 16) * 512;
#pragma unroll
                for (int bj = 0; bj < 2; ++bj)
#pragma unroll
                    for (int n = 0; n < 2; ++n) { const int col = col0 + bj * 128 + n * 16; const f32x4 bv = *(const f32x4*)(bias + col); const f16x4 yv = *(const f16x4*)(YS + ro + col);
                        const f32x4 a = acc[ai][bj][m][n]; f32x4 o;
#pragma unroll
                        for (int j = 0; j < 4; ++j) o[j] = (float)yv[j] * sigmoidf_(a[j] + bv[j]);
                        *(f16x4*)(S5 + ro + col) = cvt4(o); } }
    }
};
template <bool ADD> struct EpiUp {
    const f16* SG; int goff; const f16* T; f16* O;
    __device__ __forceinline__ void operator()(AccRef acc, const Unit& u, int wr, int wc, int fr, int fq) const {
        const int row0 = u.pm * 256 + wr * 64 + fr, col0 = u.pn * 256 + wc * 32 + 4 * fq;
#pragma unroll
        for (int ai = 0; ai < 2; ++ai)
#pragma unroll
            for (int m = 0; m < 4; ++m) { const size_t row = (size_t)(row0 + ai * 128 + m * 16);
#pragma unroll
                for (int bj = 0; bj < 2; ++bj)
#pragma unroll
                    for (int n = 0; n < 2; ++n) { const int col = col0 + bj * 128 + n * 16; const f16x4 gv = *(const f16x4*)(SG + row * 2048 + goff + col);
                        const f32x4 a = acc[ai][bj][m][n]; f32x4 o;
#pragma unroll
                        for (int j = 0; j < 4; ++j) o[j] = (float)gv[j] * a[j];
                        if (ADD) { const f16x4 tv = *(const f16x4*)(T + row * 1024 + col);
#pragma unroll
                            for (int j = 0; j < 4; ++j) o[j] += (float)tv[j]; }
                        *(f16x4*)(O + row * 1024 + col) = cvt4(o); } }
    }
};
struct EpiRes {
    const float* X; const float* gate; float* R;
    __device__ __forceinline__ void operator()(AccRef acc, const Unit& u, int wr, int wc, int fr, int fq) const {
        const int row0 = u.pm * 256 + wr * 64 + fr, col0 = u.pn * 256 + wc * 32 + 4 * fq;
        const float* gp = gate + (size_t)((u.pm * 256) >> 13) * NMOD;
        f32x4 gv[2][2];
#pragma unroll
        for (int bj = 0; bj < 2; ++bj)
#pragma unroll
            for (int n = 0; n < 2; ++n) gv[bj][n] = *(const f32x4*)(gp + col0 + bj * 128 + n * 16) + 1.0f;
#pragma unroll
        for (int ai = 0; ai < 2; ++ai)
#pragma unroll
            for (int m = 0; m < 4; ++m) { const size_t ro = (size_t)(row0 + ai * 128 + m * 16) * 1024;
#pragma unroll
                for (int bj = 0; bj < 2; ++bj)
#pragma unroll
                    for (int n = 0; n < 2; ++n) { const int col = col0 + bj * 128 + n * 16; const f32x4 xv = *(const f32x4*)(X + ro + col);
                        *(f32x4*)(R + ro + col) = xv * ALPHA + gv[bj][n] * acc[ai][bj][m][n]; } }
    }
};
struct EpiFfnIn {
    f16* H;
    __device__ __forceinline__ void operator()(AccRef acc, const Unit& u, int wr, int wc, int fr, int fq) const {
        const int row0 = u.pm * 256 + wr * 64 + fr, col0 = u.pn * 128 + wc * 32 + 4 * fq;
#pragma unroll
        for (int ai = 0; ai < 2; ++ai)
#pragma unroll
            for (int m = 0; m < 4; ++m) { f16* rp = H + (size_t)(row0 + ai * 128 + m * 16) * FH + col0;
#pragma unroll
                for (int n = 0; n < 2; ++n) { const f32x4 gt = acc[ai][0][m][n], up = acc[ai][1][m][n]; f32x4 o;
#pragma unroll
                    for (int j = 0; j < 4; ++j) o[j] = gt[j] * sigmoidf_(gt[j]) * up[j];
                    *(f16x4*)(rp + n * 16) = cvt4(o); } }
    }
};

__device__ __forceinline__ void attn_unit(const f16* __restrict__ Q, const f16* __restrict__ Kb, const f16* __restrict__ VT, f16* __restrict__ O, int bh, int qb, int lane) {
    const int b = bh >> 3, h = bh & 7, l32 = lane & 31, hi = lane >> 5, t0 = qb * 32, tq = t0 + l32;
    const size_t rowbase = (size_t)b * SEQ;
    f16x8 qf[4];
    { const f16* qp = Q + (rowbase + tq) * 512 + h * 64 + 8 * hi;
#pragma unroll
      for (int ks = 0; ks < 4; ++ks) qf[ks] = *(const f16x8*)(qp + 16 * ks); }
    f32x16 o0, o1;
#pragma unroll
    for (int r = 0; r < 16; ++r) { o0[r] = 0.f; o1[r] = 0.f; }
    float carry = 0.f;
    const f16* vbase = VT + (size_t)(bh * 64 + l32) * SEQ + 4 * hi;
    for (int kt = t0 >> 6; kt >= 0; --kt) {
        const int k0 = kt * 64;
        const f16* kp = Kb + (rowbase + k0 + l32) * 512 + h * 64 + 8 * hi;
        f32x16 z0, z1;
#pragma unroll
        for (int r = 0; r < 16; ++r) { z0[r] = 0.f; z1[r] = 0.f; }
#pragma unroll
        for (int ks = 0; ks < 4; ++ks) {
            const f16x8 a0 = *(const f16x8*)(kp + 16 * ks), a1 = *(const f16x8*)(kp + 32 * 512 + 16 * ks);
            z0 = __builtin_amdgcn_mfma_f32_32x32x16_f16(a0, qf[ks], z0, 0, 0, 0);
            z1 = __builtin_amdgcn_mfma_f32_32x32x16_f16(a1, qf[ks], z1, 0, 0, 0);
        }
        const bool diag = (k0 + 63 >= t0);
        f32x16 e0, e1;
#pragma unroll
        for (int r = 0; r < 16; ++r) {
            const int key = k0 + (r & 3) + 8 * (r >> 2) + 4 * hi;
            { const float z = z0[r] * 0.125f; const float sp = fmaxf(z, 0.f) + __logf(1.0f + __expf(-fabsf(z))); const bool ok = !diag || (key < tq);
              z0[r] = ok ? -sp : 0.f; e0[r] = ok ? (z - sp) : -1e30f; }
            { const float z = z1[r] * 0.125f; const float sp = fmaxf(z, 0.f) + __logf(1.0f + __expf(-fabsf(z))); const bool ok = !diag || (key + 32 < tq);
              z1[r] = ok ? -sp : 0.f; e1[r] = ok ? (z - sp) : -1e30f; }
        }
        float Gs[8], GP[8], ST[8];
#pragma unroll
        for (int g = 0; g < 4; ++g) { Gs[g] = (z0[4 * g] + z0[4 * g + 1]) + (z0[4 * g + 2] + z0[4 * g + 3]); Gs[4 + g] = (z1[4 * g] + z1[4 * g + 1]) + (z1[4 * g + 2] + z1[4 * g + 3]); }
#pragma unroll
        for (int i = 0; i < 8; ++i) GP[i] = __shfl_xor(Gs[i], 32);
        ST[7] = 0.f;
#pragma unroll
        for (int i = 6; i >= 0; --i) ST[i] = ST[i + 1] + (Gs[i + 1] + GP[i + 1]);
        const float tot = ST[0] + (Gs[0] + GP[0]);
#pragma unroll
        for (int i = 0; i < 8; ++i) {
            const float off = carry + ST[i] + (hi == 0 ? GP[i] : 0.f);
            if (i < 4) { const int r = 4 * i;
                const float a3 = off, a2 = a3 + z0[r + 3], a1 = a2 + z0[r + 2], a0 = a1 + z0[r + 1];
                e0[r] = __expf(e0[r] + a0); e0[r + 1] = __expf(e0[r + 1] + a1); e0[r + 2] = __expf(e0[r + 2] + a2); e0[r + 3] = __expf(e0[r + 3] + a3);
            } else { const int r = 4 * (i - 4);
                const float a3 = off, a2 = a3 + z1[r + 3], a1 = a2 + z1[r + 2], a0 = a1 + z1[r + 1];
                e1[r] = __expf(e1[r] + a0); e1[r + 1] = __expf(e1[r + 1] + a1); e1[r + 2] = __expf(e1[r + 2] + a2); e1[r + 3] = __expf(e1[r + 3] + a3);
            }
        }
        carry += tot;
#pragma unroll
        for (int j = 0; j < 4; ++j) {
            f16x8 wb;
#pragma unroll
            for (int i = 0; i < 8; ++i) wb[i] = (f16)((j < 2) ? e0[8 * (j & 1) + i] : e1[8 * (j & 1) + i]);
            const f16* vp = vbase + k0 + 16 * j;
            const f16x4 va0 = *(const f16x4*)(vp), va1 = *(const f16x4*)(vp + 8);
            const f16x4 vb0 = *(const f16x4*)(vp + (size_t)32 * SEQ), vb1 = *(const f16x4*)(vp + (size_t)32 * SEQ + 8);
            f16x8 fa, fb;
#pragma unroll
            for (int i = 0; i < 4; ++i) { fa[i] = va0[i]; fa[4 + i] = va1[i]; fb[i] = vb0[i]; fb[4 + i] = vb1[i]; }
            o0 = __builtin_amdgcn_mfma_f32_32x32x16_f16(fa, wb, o0, 0, 0, 0);
            o1 = __builtin_amdgcn_mfma_f32_32x32x16_f16(fb, wb, o1, 0, 0, 0);
        }
        if (__all(carry < -104.0f)) break;
    }
    f16* op = O + (rowbase + tq) * 512 + h * 64 + 4 * hi;
#pragma unroll
    for (int g = 0; g < 4; ++g) {
        f32x4 a, c;
#pragma unroll
        for (int j = 0; j < 4; ++j) { a[j] = o0[4 * g + j]; c[j] = o1[4 * g + j]; }
        *(f16x4*)(op + 8 * g) = cvt4(a); *(f16x4*)(op + 32 + 8 * g) = cvt4(c);
    }
}

__device__ __forceinline__ void row_stats(const f32x4 (&v)[4], float& mean, float& rstd) {
    float s = 0.f;
#pragma unroll
    for (int j = 0; j < 4; ++j) s += (v[j][0] + v[j][1]) + (v[j][2] + v[j][3]);
    mean = wave_sum(s) * (1.f / D);
    float q = 0.f;
#pragma unroll
    for (int j = 0; j < 4; ++j) { const f32x4 d = v[j] - mean; q += (d[0] * d[0] + d[1] * d[1]) + (d[2] * d[2] + d[3] * d[3]); }
    rstd = 1.0f / sqrtf(wave_sum(q) * (1.f / D) + LN_EPS);
}
__device__ __forceinline__ void row_mod(const float* xrow, const float* sh, const float* sc, f16* orow, int lane) {
    f32x4 v[4];
#pragma unroll
    for (int j = 0; j < 4; ++j) v[j] = *(const f32x4*)(xrow + 4 * lane + 256 * j);
    float mean, rstd; row_stats(v, mean, rstd);
#pragma unroll
    for (int j = 0; j < 4; ++j) { const int c = 4 * lane + 256 * j; const f32x4 s1 = *(const f32x4*)(sc + c) + 1.0f, s0 = *(const f32x4*)(sh + c);
        *(f16x4*)(orow + c) = cvt4((v[j] - mean) * rstd * s1 + s0); }
}
__device__ __forceinline__ void row_ln2(const float* rrow, const float* lg, const float* lb, float* xout, bool wh, const float* sh, const float* sc, f16* orow, int lane) {
    f32x4 v[4];
#pragma unroll
    for (int j = 0; j < 4; ++j) v[j] = *(const f32x4*)(rrow + 4 * lane + 256 * j);
    float mean, rstd; row_stats(v, mean, rstd);
#pragma unroll
    for (int j = 0; j < 4; ++j) { const int c = 4 * lane + 256 * j; v[j] = (v[j] - mean) * rstd * *(const f32x4*)(lg + c) + *(const f32x4*)(lb + c);
        *(f32x4*)(xout + c) = v[j]; }
    if (wh) {
        row_stats(v, mean, rstd);
#pragma unroll
        for (int j = 0; j < 4; ++j) { const int c = 4 * lane + 256 * j; const f32x4 s1 = *(const f32x4*)(sc + c) + 1.0f, s0 = *(const f32x4*)(sh + c);
            *(f16x4*)(orow + c) = cvt4((v[j] - mean) * rstd * s1 + s0); }
    }
}

__device__ __forceinline__ void transpose_item(const float* W, int K, int N, f16* WT, int mode, LAS float* scr, int item, int lane) {
    const int nblk = N / 32, kb = item / nblk, nb = item % nblk, k0 = 64 * kb, n0 = 32 * nb;
#pragma unroll 8
    for (int i = 0; i < 32; ++i) { const int kk = 2 * i + (lane >> 5); scr[kk * 33 + (lane & 31)] = W[(size_t)(k0 + kk) * N + n0 + (lane & 31)]; }
    asm volatile("s_waitcnt lgkmcnt(0)" ::: "memory");
    const int c = lane & 7;
#pragma unroll
    for (int j = 0; j < 4; ++j) { const int n = (lane >> 3) + 8 * j; const LAS float* s = scr + (8 * c) * 33 + n;
        f16x8 o;
#pragma unroll
        for (int e = 0; e < 8; ++e) o[e] = (f16)s[e * 33];
        const int nn = n0 + n; int drow = nn;
        if (mode == 1) { const int hh = nn < FH ? nn : nn - FH; drow = (hh >> 7) * 256 + (nn < FH ? 0 : 128) + (hh & 127); }
        *(f16x8*)(WT + (size_t)drow * K + k0 + 8 * c) = o; }
    asm volatile("s_waitcnt lgkmcnt(0)" ::: "memory");
}


#define XB_TMO      128
#define XB_XCNT(j)  (256  + 64 * (j))
#define XB_XSUB(j)  (1280 + 64 * (j))
#define XB_XGEN(j)  (2304 + 64 * (j))
#define XB_TOP      3328
#define XB_TOPGEN   3392
#define XCD_BAR_WORDS 3456
#define XB_SPIN_CAP (1u << 22)
__device__ __forceinline__ unsigned xb_ld(unsigned* p)              { return __hip_atomic_load(p, __ATOMIC_RELAXED, __HIP_MEMORY_SCOPE_AGENT); }
__device__ __forceinline__ unsigned xb_add(unsigned* p, unsigned v) { return __hip_atomic_fetch_add(p, v, __ATOMIC_RELAXED, __HIP_MEMORY_SCOPE_AGENT); }
__device__ __forceinline__ unsigned xb_xcc_id() { return (unsigned)__builtin_amdgcn_s_getreg((3 << 11) | 20) & 0xFu; }
#define XB_SPIN(cond, bar) do { unsigned _sp = 0; while (cond) { __builtin_amdgcn_s_sleep(1); \
    if ((++_sp & 255u) == 0u) { if (xb_ld(&(bar)[XB_TMO])) break; if (_sp > XB_SPIN_CAP) { atomicAdd(&(bar)[XB_TMO], 1u); break; } } } } while (0)
struct XcdBarrier { unsigned* bar; unsigned x; volatile LAS unsigned* st; };
__device__ __forceinline__ void xcd_barrier_complete(unsigned* bar, unsigned x, unsigned& nloc, unsigned& nx) {
    const unsigned G = gridDim.x * gridDim.y * gridDim.z;
    unsigned sum, cnt, mine, sp = 0u;
    for (;;) {
        sum = 0u; cnt = 0u; mine = 0u;
#pragma unroll
        for (unsigned j = 0; j < 16; ++j) { const unsigned c = xb_ld(&bar[XB_XCNT(j)]); sum += c; cnt += (c > 0u) ? 1u : 0u; mine = (j == x) ? c : mine; }
        if (sum == G) break;
        __builtin_amdgcn_s_sleep(1);
        if ((++sp & 255u) == 0u) { if (xb_ld(&bar[XB_TMO])) break; if (sp > XB_SPIN_CAP) { atomicAdd(&bar[XB_TMO], 1u); break; } }
    }
    nloc = mine > 0u ? mine : 1u; nx = cnt > 0u ? cnt : 1u;
}
__device__ __forceinline__ void xcd_barrier(const XcdBarrier& b, bool t0) {
    asm volatile("s_waitcnt vmcnt(0)" ::: "memory");
    __syncthreads();
    if (t0) {
        unsigned* bar = b.bar;
        __builtin_amdgcn_s_waitcnt(0);
        unsigned nloc = b.st[0], nx = b.st[1];
        if (nloc == 0u) { xcd_barrier_complete(bar, b.x, nloc, nx); b.st[0] = nloc; b.st[1] = nx; }
        const unsigned old = xb_add(&bar[XB_XSUB(b.x)], 1u);
        const unsigned gen = old / nloc;
        if (old + 1u == (gen + 1u) * nloc) {
            __builtin_amdgcn_fence(__ATOMIC_RELEASE, "agent");
            asm volatile("s_waitcnt vmcnt(0)" ::: "memory");
            const unsigned og = xb_add(&bar[XB_TOP], 1u);
            const unsigned tg = og / nx;
            if (og + 1u == (tg + 1u) * nx) xb_add(&bar[XB_TOPGEN], 1u);
            else XB_SPIN(xb_ld(&bar[XB_TOPGEN]) == tg, bar);
            __builtin_amdgcn_fence(__ATOMIC_ACQUIRE, "agent");
            xb_add(&bar[XB_XGEN(b.x)], 1u);
            asm volatile("s_waitcnt vmcnt(0)" ::: "memory");
        } else {
            XB_SPIN(xb_ld(&bar[XB_XGEN(b.x)]) == gen, bar);
            __builtin_amdgcn_fence(__ATOMIC_ACQUIRE, "agent");
            asm volatile("s_waitcnt vmcnt(0)" ::: "memory");
        }
    }
    __syncthreads();
}

struct Args { const float* in[24]; float* out; unsigned char* ws; };
enum { I_X = 0, I_C, I_WADA, I_BADA, I_WIN, I_WSBUP, I_ARE, I_AIM, I_LOGDT, I_BRE, I_BIM, I_CRE, I_CIM, I_DSKIP, I_WGLU, I_BGLU, I_WSSMUP, I_WOUT, I_LN1G, I_LN1B, I_WFIN, I_WFOUT, I_LN2G, I_LN2B };

template <class T> __device__ __forceinline__ T* opq(T* p) { asm volatile("" : "+s"(p)); return p; }
#define PHASE_BEGIN unsigned char* ws = opq(a.ws); float* DOUT = opq(a.out); int wv_ = wave_s; asm volatile("" : "+s"(wv_)); int tid = (wv_ << 6) | (int)__builtin_amdgcn_mbcnt_hi(~0u, __builtin_amdgcn_mbcnt_lo(~0u, 0u)); asm volatile("" : "+v"(tid)); \
    const int lane = tid & 63, wave = __builtin_amdgcn_readfirstlane(tid >> 6), gw = bid * 8 + wave, gtid = bid * 512 + tid; (void)lane; (void)wave; (void)gw; (void)gtid; (void)DOUT; (void)ws;

__global__ void __launch_bounds__(512, 2) mk_fwd(Args a) {
    extern __shared__ __attribute__((aligned(16))) unsigned char lds_raw[];
    LAS unsigned char* lds = (LAS unsigned char*)lds_raw;
    cg::grid_group grid = cg::this_grid();
    const int G = gridDim.x, bid = blockIdx.x, NGW = G * 8, NT = G * 512;
    const int wave_s = __builtin_amdgcn_readfirstlane((int)threadIdx.x >> 6);
    const unsigned xcc_s = xb_xcc_id();
    if (threadIdx.x < 2) ((volatile LAS unsigned*)(lds + 131072))[threadIdx.x] = 0u;
    if (threadIdx.x == 0) (void)xb_add((unsigned*)(a.ws + WS_BAR) + XB_XCNT(xcc_s), 1u);
    __syncthreads();
#define is_t0() (wave_s == 0 && __builtin_amdgcn_mbcnt_hi(~0u, __builtin_amdgcn_mbcnt_lo(~0u, 0u)) == 0u)

    {
        PHASE_BEGIN
        float* mod = (float*)(ws + WS_MOD);
        LAS float* scr = (LAS float*)(lds + wave * 16384);
        constexpr int I0 = 16 * 128, I1 = 8 * 32, I2 = 8 * 16, I3 = 8 * 32, I4 = 16 * 32, I5 = 16 * 176, I6 = 44 * 32, IL = I0 + I1 + I2 + I3 + I4 + I5 + I6;
        for (int it = gw; it < 2 * IL; it += NGW) {
            const int l = it / IL; int r = it % IL; unsigned char* wl = ws + (size_t)l * WS_WL;
            if (r < I0) { transpose_item(a.in[I_WIN] + (size_t)l * D * INC, D, INC, (f16*)(wl + W_IN), 0, scr, r, lane); continue; } r -= I0;
            if (r < I1) { transpose_item(a.in[I_WSBUP] + (size_t)l * 512 * D, 512, D, (f16*)(wl + W_SBUP), 0, scr, r, lane); continue; } r -= I1;
            if (r < I2) { transpose_item(a.in[I_WGLU] + (size_t)l * 512 * 512, 512, 512, (f16*)(wl + W_GLU), 0, scr, r, lane); continue; } r -= I2;
            if (r < I3) { transpose_item(a.in[I_WSSMUP] + (size_t)l * 512 * D, 512, D, (f16*)(wl + W_SSMUP), 0, scr, r, lane); continue; } r -= I3;
            if (r < I4) { transpose_item(a.in[I_WOUT] + (size_t)l * D * D, D, D, (f16*)(wl + W_OUT), 0, scr, r, lane); continue; } r -= I4;
            if (r < I5) { transpose_item(a.in[I_WFIN] + (size_t)l * D * 2 * FH, D, 2 * FH, (f16*)(wl + W_FIN), 1, scr, r, lane); continue; } r -= I5;
            transpose_item(a.in[I_WFOUT] + (size_t)l * FH * D, FH, D, (f16*)(wl + W_FOUT), 0, scr, r, lane);
        }
        for (int it = gw; it < 1536; it += NGW) {
            const int l = it / 768, r = it % 768, jb = r >> 3, kc = r & 7, j = jb * 64 + lane;
            const float* w = a.in[I_WADA] + (size_t)l * D * NMOD + (size_t)(kc * 128) * NMOD + j;
            const float* cc = a.in[I_C] + kc * 128;
            float a0 = 0.f, a1 = 0.f, a2 = 0.f, a3 = 0.f;
            for (int k = 0; k < 128; ++k) {
                const float wv = w[(size_t)k * NMOD];
                const float c0 = cc[k], c1 = cc[D + k], c2 = cc[2 * D + k], c3 = cc[3 * D + k];
                a0 += c0 * sigmoidf_(c0) * wv; a1 += c1 * sigmoidf_(c1) * wv; a2 += c2 * sigmoidf_(c2) * wv; a3 += c3 * sigmoidf_(c3) * wv;
            }
            if (kc == 0) { const float bv = a.in[I_BADA][l * NMOD + j]; a0 += bv; a1 += bv; a2 += bv; a3 += bv; }
            atomicAdd(mod + (size_t)(l * 4 + 0) * NMOD + j, a0); atomicAdd(mod + (size_t)(l * 4 + 1) * NMOD + j, a1);
            atomicAdd(mod + (size_t)(l * 4 + 2) * NMOD + j, a2); atomicAdd(mod + (size_t)(l * 4 + 3) * NMOD + j, a3);
        }
        for (int rep_ = 0; rep_ < REP_TABLES; ++rep_) {
        for (int e = gtid; e < 2 * 32 * 65536; e += NT) {
            const int col = e & 255, row = (e >> 8) & 255, lg = e >> 16;
            float val = 0.f;
            if (row < 128) {
                const int p = row & 63, isim = row >> 6, j = col >> 4, ci = col & 15;
                const float are = a.in[I_ARE][lg * 64 + p], aim = a.in[I_AIM][lg * 64 + p], dt = expf(a.in[I_LOGDT][lg]);
                float lr, li; cexp_k(are * dt, aim * dt, 1.0f, lr, li);
                const float nr = lr - 1.0f, ni = li, den = 1.0f / (are * are + aim * aim);
                const float cr = (nr * are + ni * aim) * den, ci_ = (ni * are - nr * aim) * den;
                float pr, pi; cexp_k(are * dt, aim * dt, (float)(15 - j), pr, pi);
                const float qr = pr * cr - pi * ci_, qi = pr * ci_ + pi * cr;
                const float br = a.in[I_BRE][(size_t)(lg * 64 + p) * 16 + ci], bi = a.in[I_BIM][(size_t)(lg * 64 + p) * 16 + ci];
                val = isim ? (qr * bi + qi * br) : (qr * br - qi * bi);
            }
            const int l = lg >> 5, g = lg & 31;
            ((f16*)(ws + WS_SSM + (size_t)l * WS_SSML + S_W1))[((size_t)(g * 256 + row)) * 256 + col] = (f16)val;
        }
        for (int e = gtid; e < 2 * 32 * 32768; e += NT) {
            const int c2 = e & 127, row = (e >> 7) & 255, lg = e >> 15;
            const int p = c2 & 63, isim = c2 >> 6, i = row >> 4, co = row & 15;
            const float are = a.in[I_ARE][lg * 64 + p], aim = a.in[I_AIM][lg * 64 + p], dt = expf(a.in[I_LOGDT][lg]);
            float pr, pi; cexp_k(are * dt, aim * dt, (float)(i + 1), pr, pi);
            const float cr = a.in[I_CRE][(size_t)(lg * 16 + co) * 64 + p], ci_ = a.in[I_CIM][(size_t)(lg * 16 + co) * 64 + p];
            const float val = isim ? -(cr * pi + ci_ * pr) : (cr * pr - ci_ * pi);
            const int l = lg >> 5, g = lg & 31;
            ((f16*)(ws + WS_SSM + (size_t)l * WS_SSML + S_TW))[((size_t)(g * 256 + row)) * 384 + 256 + c2] = (f16)val;
        }
        for (int e = gtid; e < 2 * 32 * 16 * 16; e += NT) {
            const int co = e & 15, d = (e >> 4) & 15, lg = e >> 8;
            const float dt = expf(a.in[I_LOGDT][lg]);
            float accv[16];
#pragma unroll
            for (int ci = 0; ci < 16; ++ci) accv[ci] = 0.f;
            for (int p = 0; p < 64; ++p) {
                const float are = a.in[I_ARE][lg * 64 + p], aim = a.in[I_AIM][lg * 64 + p];
                float lr, li; cexp_k(are * dt, aim * dt, 1.0f, lr, li);
                const float nr = lr - 1.0f, ni = li, den = 1.0f / (are * are + aim * aim);
                const float cr = (nr * are + ni * aim) * den, ci_ = (ni * are - nr * aim) * den;
                float pr, pi; cexp_k(are * dt, aim * dt, (float)d, pr, pi);
                const float qr = pr * cr - pi * ci_, qi = pr * ci_ + pi * cr;
                const float c_r = a.in[I_CRE][(size_t)(lg * 16 + co) * 64 + p], c_i = a.in[I_CIM][(size_t)(lg * 16 + co) * 64 + p];
                const float er = c_r * qr - c_i * qi, ei = c_r * qi + c_i * qr;
                const float* brp = a.in[I_BRE] + (size_t)(lg * 64 + p) * 16; const float* bip = a.in[I_BIM] + (size_t)(lg * 64 + p) * 16;
#pragma unroll
                for (int ci = 0; ci < 16; ++ci) accv[ci] += er * brp[ci] - ei * bip[ci];
            }
            const int l = lg >> 5, g = lg & 31;
            float* kd = (float*)(ws + WS_SSM + (size_t)l * WS_SSML + S_KD) + ((size_t)((g * 16 + d) * 16 + co)) * 16;
#pragma unroll
            for (int ci = 0; ci < 16; ++ci) kd[ci] = accv[ci];
        }
        }
    }
    grid.sync();
    {
        PHASE_BEGIN
        const float* mod = (const float*)(ws + WS_MOD); f16* XN = (f16*)(ws + WS_XN);
        for (int rep_ = 0; rep_ < REP_ROW; ++rep_) for (int m = gw; m < M; m += NGW) { const int b = m >> 13; const float* mb = mod + (size_t)b * NMOD;
            row_mod(a.in[I_X] + (size_t)m * D, mb, mb + D, XN + (size_t)m * D, lane); }
        for (int e = gtid; e < 2 * 32 * 65536; e += NT) {
            const int col = e & 255, row = (e >> 8) & 255, lg = e >> 16, l = lg >> 5, g = lg & 31;
            const int i = row >> 4, co = row & 15, j = col >> 4, ci = col & 15;
            float val = 0.f;
            if (j <= i) val = ((const float*)(ws + WS_SSM + (size_t)l * WS_SSML + S_KD))[((size_t)((g * 16 + (i - j)) * 16 + co)) * 16 + ci];
            ((f16*)(ws + WS_SSM + (size_t)l * WS_SSML + S_TW))[((size_t)(g * 256 + row)) * 384 + col] = (f16)val;
        }
    }
    GSYNC();

#pragma unroll 1
    for (int l = 0; l < 2; ++l) {
        { PHASE_BEGIN
          pg8::Gemm g{(const f16*)(ws + WS_XN), (const f16*)(ws + (size_t)l * WS_WL + W_IN), D, D, D}; pg8::StaticOrder S; S.init(M, INC, G, bid);
          EpiInProj E{(f16*)(ws + WS_Q), (f16*)(ws + WS_K), (f16*)(ws + WS_VT), (f16*)(ws + WS_UG), (f16*)(ws + WS_SG)};
          pg8::gemm_phase<EpiInProj, pg8::StaticOrder, true>(lds, g, S, E, wave); }
        GSYNC();
        { PHASE_BEGIN
          for (int rep_ = 0; rep_ < REP_ATTN; ++rep_) for (int u = gw; u < 8192; u += NGW) attn_unit((const f16*)(ws + WS_Q), (const f16*)(ws + WS_K), (const f16*)(ws + WS_VT), (f16*)(ws + WS_O), u >> 8, u & 255, lane); }
        __syncthreads();
        { PHASE_BEGIN
          pg8::Gemm g{(const f16*)(ws + WS_UG), (const f16*)(ws + WS_SSM + (size_t)l * WS_SSML + S_W1), 256, 384, 256}; pg8::GroupOrder S{G, bid};
          EpiSsm1 E{(float*)(ws + WS_S)};
          pg8::gemm_phase<EpiSsm1, pg8::GroupOrder, false>(lds, g, S, E, wave); }
        GSYNC();
        { PHASE_BEGIN
          for (int rep_ = 0; rep_ < REP_SCAN; ++rep_) if (wave == 0 && bid < 128) {
            const float* Sb = (const float*)(ws + WS_S); f16* Ug = (f16*)(ws + WS_UG);
            const int b = bid >> 5, g = bid & 31, lg = l * 32 + g, p = lane;
            const float are = a.in[I_ARE][lg * 64 + p], aim = a.in[I_AIM][lg * 64 + p], dt = expf(a.in[I_LOGDT][lg]);
            float ar, ai; cexp_k(are * dt, aim * dt, 16.0f, ar, ai);
            float sr = 0.f, si = 0.f;
            const size_t row0 = (size_t)g * 2048 + (size_t)b * 512;
            for (int c0 = 0; c0 < 512; c0 += 8) {
                float vr[8], vi[8];
#pragma unroll
                for (int q = 0; q < 8; ++q) { const float* sp = Sb + (row0 + c0 + q) * 128 + p; vr[q] = sp[0]; vi[q] = sp[64]; }
#pragma unroll
                for (int q = 0; q < 8; ++q) {
                    f16* up = Ug + (row0 + c0 + q) * 384 + 256 + p; up[0] = (f16)sr; up[64] = (f16)si;
                    const float nr = ar * sr - ai * si + vr[q], ni = ar * si + ai * sr + vi[q]; sr = nr; si = ni;
                }
            }
          } }
        GSYNC();
        { PHASE_BEGIN
          pg8::Gemm g{(const f16*)(ws + WS_UG), (const f16*)(ws + WS_SSM + (size_t)l * WS_SSML + S_TW), 384, 384, 384}; pg8::GroupOrder S{G, bid};
          EpiSsm3 E{(const f16*)(ws + WS_UG), a.in[I_DSKIP] + l * 512, (f16*)(ws + WS_YS)};
          pg8::gemm_phase<EpiSsm3, pg8::GroupOrder, false>(lds, g, S, E, wave); }
        GSYNC();
        { PHASE_BEGIN
          pg8::Gemm g{(const f16*)(ws + WS_YS), (const f16*)(ws + (size_t)l * WS_WL + W_GLU), 512, 512, 512}; pg8::StaticOrder S; S.init(M, 512, G, bid);
          EpiGlu E{(const f16*)(ws + WS_YS), a.in[I_BGLU] + l * 512, (f16*)(ws + WS_S5)};
          pg8::gemm_phase<EpiGlu, pg8::StaticOrder, true>(lds, g, S, E, wave); }
        { PHASE_BEGIN
          pg8::Gemm g{(const f16*)(ws + WS_O), (const f16*)(ws + (size_t)l * WS_WL + W_SBUP), 512, 512, 512}; pg8::StaticOrder S; S.init(M, D, G, bid);
          EpiUp<false> E{(const f16*)(ws + WS_SG), 0, nullptr, (f16*)(ws + WS_TMP)};
          pg8::gemm_phase<EpiUp<false>, pg8::StaticOrder, true>(lds, g, S, E, wave); }
        GSYNC();
        { PHASE_BEGIN
          pg8::Gemm g{(const f16*)(ws + WS_S5), (const f16*)(ws + (size_t)l * WS_WL + W_SSMUP), 512, 512, 512}; pg8::StaticOrder S; S.init(M, D, G, bid);
          EpiUp<true> E{(const f16*)(ws + WS_SG), 1024, (const f16*)(ws + WS_TMP), (f16*)(ws + WS_MRG)};
          pg8::gemm_phase<EpiUp<true>, pg8::StaticOrder, true>(lds, g, S, E, wave); }
        GSYNC();
        { PHASE_BEGIN
          pg8::Gemm g{(const f16*)(ws + WS_MRG), (const f16*)(ws + (size_t)l * WS_WL + W_OUT), D, D, D}; pg8::StaticOrder S; S.init(M, D, G, bid);
          EpiRes E{l == 0 ? a.in[I_X] : (const float*)DOUT, (const float*)(ws + WS_MOD) + (size_t)l * 4 * NMOD + 2 * D, DOUT};
          pg8::gemm_phase<EpiRes, pg8::StaticOrder, true>(lds, g, S, E, wave); }
        GSYNC();
        { PHASE_BEGIN
          const float* modl = (const float*)(ws + WS_MOD) + (size_t)l * 4 * NMOD; f16* XN = (f16*)(ws + WS_XN);
          for (int m = gw; m < M; m += NGW) { const int b = m >> 13; const float* mb = modl + (size_t)b * NMOD;
            row_ln2(DOUT + (size_t)m * D, a.in[I_LN1G] + l * D, a.in[I_LN1B] + l * D, DOUT + (size_t)m * D, true, mb + 3 * D, mb + 4 * D, XN + (size_t)m * D, lane); } }
        GSYNC();
        { PHASE_BEGIN
          pg8::Gemm g{(const f16*)(ws + WS_XN), (const f16*)(ws + (size_t)l * WS_WL + W_FIN), D, D, D}; pg8::StaticOrder S; S.init(M, 2 * FH, G, bid);
          EpiFfnIn E{(f16*)(ws + WS_H)};
          pg8::gemm_phase<EpiFfnIn, pg8::StaticOrder, true>(lds, g, S, E, wave); }
        GSYNC();
        { PHASE_BEGIN
          pg8::Gemm g{(const f16*)(ws + WS_H), (const f16*)(ws + (size_t)l * WS_WL + W_FOUT), FH, FH, FH}; pg8::StaticOrder S; S.init(M, D, G, bid);
          EpiRes E{DOUT, (const float*)(ws + WS_MOD) + (size_t)l * 4 * NMOD + 5 * D, (float*)(ws + WS_R2)};
          pg8::gemm_phase<EpiRes, pg8::StaticOrder, true>(lds, g, S, E, wave); }
        GSYNC();
        { PHASE_BEGIN
          const float* modn = (const float*)(ws + WS_MOD) + (size_t)4 * NMOD; f16* XN = (f16*)(ws + WS_XN); const float* R2 = (const float*)(ws + WS_R2);
          for (int m = gw; m < M; m += NGW) { const int b = m >> 13; const float* mb = modn + (size_t)b * NMOD;
            row_ln2(R2 + (size_t)m * D, a.in[I_LN2G] + l * D, a.in[I_LN2B] + l * D, DOUT + (size_t)m * D, l == 0, mb, mb + D, XN + (size_t)m * D, lane); } }
        if (l == 0) GSYNC();
    }
}

extern "C" void kernel_launch(void* const* d_in, const int* in_sizes, int n_in, void* d_out, int out_size, void* d_ws, size_t ws_size, hipStream_t stream) {
    static int grid = 0;
    if (grid == 0) {
        if (n_in != 24 || in_sizes[0] != M * D || out_size != M * D || ws_size < WS_NEED) { fprintf(stderr, "kernel_launch: unexpected shapes (n_in %d, in0 %d, out %d, ws %zu)\n", n_in, n_in > 0 ? in_sizes[0] : -1, out_size, ws_size); grid = -1; return; }
        int dev = 0, cus = 0, per_cu = 0;
        if (hipGetDevice(&dev) != hipSuccess || hipDeviceGetAttribute(&cus, hipDeviceAttributeMultiprocessorCount, dev) != hipSuccess) { grid = -1; return; }
        if (hipFuncSetAttribute((const void*)mk_fwd, hipFuncAttributeMaxDynamicSharedMemorySize, LDS_BYTES) != hipSuccess) { fprintf(stderr, "kernel_launch: hipFuncSetAttribute failed\n"); grid = -1; return; }
        if (hipOccupancyMaxActiveBlocksPerMultiprocessor(&per_cu, (const void*)mk_fwd, 512, LDS_BYTES) != hipSuccess || per_cu < 1) { fprintf(stderr, "kernel_launch: occupancy query says %d blocks per CU\n", per_cu); per_cu = 1; }
        (void)hipGetLastError();
        grid = cus * 1;
    }
    if (grid < 0) return;
    (void)hipMemsetAsync((char*)d_ws + WS_MOD, 0, ZERO_BYTES, stream);
    Args a{};
    for (int i = 0; i < 24; ++i) a.in[i] = (const float*)d_in[i];
    a.out = (float*)d_out; a.ws = (unsigned char*)d_ws;
    void* args[] = {&a};
    hipError_t e = hipLaunchCooperativeKernel((const void*)mk_fwd, dim3(grid), dim3(512), args, LDS_BYTES, stream);
    if (e != hipSuccess) fprintf(stderr, "cooperative launch failed: %s (grid %d)\n", hipGetErrorString(e), grid);
}
```

```cpp
#include <hip/hip_runtime.h>
#include <hip/hip_cooperative_groups.h>
#include <cstdio>
#include <cstdint>
namespace cg = cooperative_groups;

#define LAS __attribute__((address_space(3)))
typedef _Float16 f16;
typedef _Float16 f16x8 __attribute__((ext_vector_type(8)));
typedef _Float16 f16x4 __attribute__((ext_vector_type(4)));
typedef float f32x4 __attribute__((ext_vector_type(4)));
typedef float f32x16 __attribute__((ext_vector_type(16)));

constexpr int D = 1024, NB = 4, SEQ = 8192, M = NB * SEQ, NMOD = 6 * D;
constexpr int INC = 4096, FH = 2816;
constexpr float ALPHA = 1.41421356237309515f;
constexpr float LN_EPS = 1e-5f;
constexpr size_t MiB = 1u << 20;
constexpr size_t WS_WL = 29 * MiB;
constexpr size_t W_IN = 0, W_SBUP = 8 * MiB, W_GLU = 9 * MiB, W_SSMUP = 9 * MiB + MiB / 2, W_OUT = 10 * MiB + MiB / 2, W_FIN = 12 * MiB + MiB / 2, W_FOUT = 23 * MiB + MiB / 2;
constexpr size_t WS_SSM = 58 * MiB, WS_SSML = 10 * MiB + MiB / 2;
constexpr size_t S_TW = 0, S_W1 = 6 * MiB, S_KD = 10 * MiB;
constexpr size_t WS_MOD = 79 * MiB;
constexpr size_t MOD_BYTES = 2 * 4 * 6144 * 4;
constexpr size_t WS_BAR = WS_MOD + 256 * 1024, ZERO_BYTES = 256 * 1024 + 16 * 1024;
constexpr size_t WS_XN = 80 * MiB;
constexpr size_t WS_Q = 144 * MiB, WS_K = 176 * MiB, WS_VT = 208 * MiB, WS_UG = 240 * MiB, WS_SG = 288 * MiB, WS_O = 416 * MiB, WS_S = 448 * MiB, WS_YS = 480 * MiB;
constexpr size_t WS_S5 = WS_Q, WS_TMP = WS_K, WS_MRG = WS_O;
constexpr size_t WS_H = 144 * MiB, WS_R2 = 320 * MiB;
constexpr size_t WS_NEED = 512 * MiB;
constexpr int LDS_BYTES = 147456;
#define REP_ATTN 1
#define REP_SCAN 1
#define REP_TABLES 1
#define REP_ROW 1
#define REP_SYNC 1
#define GSYNC() do { XcdBarrier xb_; xb_.bar = (unsigned*)(opq(a.ws) + WS_BAR); { unsigned x_ = xcc_s; asm volatile("" : "+s"(x_)); xb_.x = x_; } xb_.st = (volatile LAS unsigned*)(lds + 131072); xcd_barrier(xb_, is_t0()); } while (0)

namespace pg8 {
constexpr int BM = 256, BK = 64, HALF = 128, HTB = HALF * BK * 2, NXCD = 8, WGM = 8;
__host__ __device__ __forceinline__ int lds_byte(int r, int c) { const int st = (r >> 4) * 2 + (c >> 5), rr = r & 15, cc = c & 31, ob = rr * 64 + cc * 2; return st * 1024 + (ob ^ (((ob >> 9) & 1) << 5)); }
__host__ __device__ __forceinline__ void stage_rc(int b, int& R, int& C) { const int st = b / 1024, sb = b % 1024, swz = sb ^ (((sb >> 9) & 1) << 5); R = (st >> 1) * 16 + swz / 64; C = (st & 1) * 32 + (swz % 64) / 2; }

struct Unit { int pm, pn; };
struct Gemm { const f16* A; const f16* Bt; int K, lda, ldb; };

struct StaticOrder {
    int nM, nN, nwg, G, c;
    __device__ void init(int M_, int N_, int G_, int c_) { nM = M_ / BM; nN = N_ / BM; nwg = nM * nN; G = G_; c = c_; }
    __device__ bool next(int i, Unit& u) const {
        const long L = (long)i * G + c; if (L >= nwg) return false;
        int wgid = (int)L; { const int q = nwg / NXCD, r = nwg % NXCD, xcd = wgid % NXCD, off = wgid / NXCD; wgid = (xcd < r ? xcd * (q + 1) : r * (q + 1) + (xcd - r) * q) + off; }
        const int nig = WGM * nN, gid = wgid / nig, fm = gid * WGM, gsz = (nM - fm) < WGM ? (nM - fm) : WGM;
        u.pm = fm + ((wgid % nig) % gsz); u.pn = (wgid % nig) / gsz; return true;
    }
};
struct GroupOrder {
    int G, c;
    __device__ bool next(int i, Unit& u) const { const int L = i * G + c; if (L >= 256) return false; u.pm = L; u.pn = L >> 3; return true; }
};

template <class Epi, class Sched, bool ALIGN_EPI>
__device__ __forceinline__ void gemm_phase(LAS unsigned char* lds, const Gemm g, const Sched& S, const Epi& E, int wid_in) {
    int tid = (wid_in << 6) | (int)__builtin_amdgcn_mbcnt_hi(~0u, __builtin_amdgcn_mbcnt_lo(~0u, 0u)); asm volatile("" : "+v"(tid));
    const int wid = __builtin_amdgcn_readfirstlane(tid >> 6), lane = tid & 63, wr = wid >> 2, wc = wid & 3, fr = lane & 15, fq = lane >> 4;
    const int K = g.K, nt = K / BK;
    unsigned voffA[2], voffB[2];
#pragma unroll
    for (int i = 0; i < 2; ++i) { int R, C; stage_rc(tid * 16 + i * 8192, R, C);
        voffA[i] = (unsigned)(R * g.lda + C) * 2u; voffB[i] = (unsigned)(R * g.ldb + C) * 2u; }
    const size_t kstep = (size_t)(BK * 2);
    const size_t hstepA = (size_t)HALF * g.lda * 2, hstepB = (size_t)HALF * g.ldb * 2;
    const size_t tstepA = 2 * hstepA, tstepB = 2 * hstepB;
    const unsigned ldsw = (unsigned)wid * 1024u;
    const int aoff = lds_byte(wr * 64 + fr, fq * 8), boff = lds_byte(wc * 32 + fr, fq * 8);
#define PG8_SA(b, h) (((b) * 2 + (h)) * HTB)
#define PG8_SB(b, h) ((4 + (b) * 2 + (h)) * HTB)
#define PG8_STAGE(bufoff, gbase, voff) do { _Pragma("unroll") for (int _i = 0; _i < 2; ++_i) \
        __builtin_amdgcn_global_load_lds((const unsigned*)((const char*)(gbase) + (voff)[_i]), (LAS unsigned*)(lds + (bufoff) + ldsw + _i * 8192), 16, 0, 0); } while (0)
#define PG8_LDA(dst, b, h) do { _Pragma("unroll") for (int m = 0; m < 4; ++m) _Pragma("unroll") for (int k = 0; k < 2; ++k) dst[m][k] = *(const LAS f16x8*)(lds + PG8_SA(b, h) + aoff + m * 2048 + k * 1024); } while (0)
#define PG8_LDB(dst, b, h) do { _Pragma("unroll") for (int n = 0; n < 2; ++n) _Pragma("unroll") for (int k = 0; k < 2; ++k) dst[n][k] = *(const LAS f16x8*)(lds + PG8_SB(b, h) + boff + n * 2048 + k * 1024); } while (0)
#define PG8_MMA(ai, bj, At, Bt) do { __builtin_amdgcn_s_setprio(1); _Pragma("unroll") for (int m = 0; m < 4; ++m) _Pragma("unroll") for (int n = 0; n < 2; ++n) _Pragma("unroll") for (int k = 0; k < 2; ++k) \
        acc[ai][bj][m][n] = __builtin_amdgcn_mfma_f32_16x16x32_f16(Bt[n][k], At[m][k], acc[ai][bj][m][n], 0, 0, 0); __builtin_amdgcn_s_setprio(0); } while (0)
#define PG8_WAIT_V(n) asm volatile("s_waitcnt vmcnt(" #n ")" ::: "memory")
#define PG8_WAIT_L(n) asm volatile("s_waitcnt lgkmcnt(" #n ")" ::: "memory")
#define PG8_BAR __builtin_amdgcn_s_barrier()
#define PG8_SCHED __builtin_amdgcn_sched_barrier(0)
    Unit cur, nxt; int ui = 0;
    if (!S.next(0, cur)) return;
    f32x4 acc[2][2][4][2];
#pragma unroll
    for (int a = 0; a < 2; ++a)
#pragma unroll
        for (int b = 0; b < 2; ++b)
#pragma unroll
            for (int m = 0; m < 4; ++m)
#pragma unroll
                for (int n = 0; n < 2; ++n) acc[a][b][m][n] = (f32x4){0.f, 0.f, 0.f, 0.f};
    f16x8 At[4][2], B0[2][2], B1[2][2];
    const char* cA = (const char*)g.A + (size_t)cur.pm * tstepA; const char* cB = (const char*)g.Bt + (size_t)cur.pn * tstepB;
    PG8_STAGE(PG8_SB(0, 0), cB, voffB); PG8_STAGE(PG8_SB(0, 1), cB + hstepB, voffB); PG8_STAGE(PG8_SA(0, 0), cA, voffA); PG8_STAGE(PG8_SA(0, 1), cA + hstepA, voffA);
    if (wr == 1) PG8_BAR;
    PG8_WAIT_V(2); PG8_BAR;
    PG8_STAGE(PG8_SB(1, 0), cB + kstep, voffB); PG8_STAGE(PG8_SA(1, 0), cA + kstep, voffA); PG8_STAGE(PG8_SB(1, 1), cB + hstepB + kstep, voffB);
    PG8_WAIT_V(6); PG8_BAR;
    for (;;) {
        const bool has_next = S.next(ui + 1, nxt);
        const char* nA = has_next ? (const char*)g.A + (size_t)nxt.pm * tstepA : cA; const char* nB = has_next ? (const char*)g.Bt + (size_t)nxt.pn * tstepB : cB;
        for (int t = 0; t < nt; t += 2) {
            const bool last = (t == nt - 2);
            const char* a1 = cA + (size_t)(t + 1) * kstep;
            const char* a2 = last ? nA : cA + (size_t)(t + 2) * kstep; const char* b2 = last ? nB : cB + (size_t)(t + 2) * kstep;
            const char* a3 = a2 + kstep; const char* b3 = b2 + kstep;
            PG8_LDB(B0, 0, 0); PG8_LDB(B1, 0, 1); PG8_SCHED; PG8_LDA(At, 0, 0); PG8_STAGE(PG8_SA(1, 1), a1 + hstepA, voffA);
            PG8_WAIT_V(8); PG8_WAIT_L(0); PG8_BAR; PG8_MMA(0, 0, At, B0); PG8_MMA(0, 1, At, B1); PG8_BAR; PG8_SCHED;
            PG8_LDA(At, 0, 1); PG8_STAGE(PG8_SB(0, 0), b2, voffB); PG8_STAGE(PG8_SB(0, 1), b2 + hstepB, voffB); PG8_STAGE(PG8_SA(0, 0), a2, voffA);
            PG8_WAIT_V(8); PG8_WAIT_L(0); PG8_BAR; PG8_MMA(1, 0, At, B0); PG8_MMA(1, 1, At, B1); PG8_BAR; PG8_SCHED;
            PG8_LDB(B0, 1, 0); PG8_LDB(B1, 1, 1); PG8_SCHED; PG8_LDA(At, 1, 0); PG8_STAGE(PG8_SA(0, 1), a2 + hstepA, voffA);
            PG8_WAIT_V(8); PG8_WAIT_L(0); PG8_BAR; PG8_MMA(0, 0, At, B0); PG8_MMA(0, 1, At, B1); PG8_BAR; PG8_SCHED;
            PG8_LDA(At, 1, 1); PG8_STAGE(PG8_SB(1, 0), b3, voffB); PG8_STAGE(PG8_SB(1, 1), b3 + hstepB, voffB); PG8_STAGE(PG8_SA(1, 0), a3, voffA);
            PG8_WAIT_V(8); PG8_WAIT_L(0); PG8_BAR; PG8_MMA(1, 0, At, B0); PG8_MMA(1, 1, At, B1); PG8_BAR; PG8_SCHED;
        }
        if constexpr (ALIGN_EPI) { if (wr == 0) PG8_BAR; }
        { int l2 = (int)__builtin_amdgcn_mbcnt_hi(~0u, __builtin_amdgcn_mbcnt_lo(~0u, 0u)); asm volatile("" : "+v"(l2));
          E(acc, cur, wr, wc, l2 & 15, l2 >> 4); }
        if (!has_next) break;
#pragma unroll
        for (int a = 0; a < 2; ++a)
#pragma unroll
            for (int b = 0; b < 2; ++b)
#pragma unroll
                for (int m = 0; m < 4; ++m)
#pragma unroll
                    for (int n = 0; n < 2; ++n) acc[a][b][m][n] = (f32x4){0.f, 0.f, 0.f, 0.f};
        cur = nxt; cA = nA; cB = nB; ++ui;
        if constexpr (ALIGN_EPI) { if (wr == 1) PG8_BAR; }
    }
    PG8_WAIT_V(0);
    if constexpr (!ALIGN_EPI) { if (wr == 0) PG8_BAR; }
    PG8_BAR;
#undef PG8_SA
#undef PG8_SB
#undef PG8_STAGE
#undef PG8_LDA
#undef PG8_LDB
#undef PG8_MMA
#undef PG8_WAIT_V
#undef PG8_WAIT_L
#undef PG8_BAR
#undef PG8_SCHED
}
}
using pg8::Unit;
typedef const f32x4 (&AccRef)[2][2][4][2];

__device__ __forceinline__ float sigmoidf_(float x) { return 1.0f / (1.0f + __expf(-x)); }
__device__ __forceinline__ float gelu_tanh(float y) { const float t = 0.7978845608028654f * (y + 0.044715f * y * y * y); const float e = __expf(2.0f * t); const float th = 1.0f - 2.0f / (e + 1.0f); return 0.5f * y * (1.0f + th); }
__device__ __forceinline__ f16x4 cvt4(f32x4 v) { f16x4 o; o[0] = (f16)v[0]; o[1] = (f16)v[1]; o[2] = (f16)v[2]; o[3] = (f16)v[3]; return o; }
__device__ __forceinline__ float wave_sum(float v) {
#pragma unroll
    for (int o = 1; o < 64; o <<= 1) v += __shfl_xor(v, o);
    return v;
}
__device__ __forceinline__ void cexp_k(float re, float im, float k, float& er, float& ei) {
    const float mag = expf(k * re);
    float turns = k * im * 0.15915494309189535f; turns -= rintf(turns);
    const float ang = turns * 6.283185307179586f;
    er = mag * cosf(ang); ei = mag * sinf(ang);
}

__device__ __forceinline__ void cexp_fast(float re, float im, float k, float& er, float& ei) {
    const float mag = __expf(k * re);
    float turns = k * im * 0.15915494309189535f; turns -= rintf(turns);
    er = mag * __builtin_amdgcn_cosf(turns); ei = mag * __builtin_amdgcn_sinf(turns);
}

struct EpiInProj {
    f16* Q; f16* Kb; f16* VT; f16* Ug; f16* SG;
    __device__ __forceinline__ void operator()(AccRef acc, const Unit& u, int wr, int wc, int fr, int fq) const {
        const int pn = u.pn, row0 = u.pm * 256 + wr * 64 + fr, cl0 = wc * 32 + 4 * fq;
        if (pn < 4) {
            f16* base = (pn < 2 ? Q : Kb) + (pn & 1) * 256 + cl0;
#pragma unroll
            for (int ai = 0; ai < 2; ++ai)
#pragma unroll
                for (int m = 0; m < 4; ++m) { f16* rp = base + (size_t)(row0 + ai * 128 + m * 16) * 512;
#pragma unroll
                    for (int bj = 0; bj < 2; ++bj)
#pragma unroll
                        for (int n = 0; n < 2; ++n) *(f16x4*)(rp + bj * 128 + n * 16) = cvt4(acc[ai][bj][m][n]); }
        } else if (pn < 6) {
#pragma unroll
            for (int ai = 0; ai < 2; ++ai)
#pragma unroll
                for (int m = 0; m < 4; ++m) { const int row = row0 + ai * 128 + m * 16, b = row >> 13, s = row & 8191;
#pragma unroll
                    for (int bj = 0; bj < 2; ++bj)
#pragma unroll
                        for (int n = 0; n < 2; ++n) { const int col = (pn - 4) * 256 + bj * 128 + n * 16 + cl0;
#pragma unroll
                            for (int j = 0; j < 4; ++j) VT[(size_t)(b * 512 + col + j) * 8192 + s] = (f16)acc[ai][bj][m][n][j]; } }
        } else if (pn < 8) {
#pragma unroll
            for (int ai = 0; ai < 2; ++ai)
#pragma unroll
                for (int m = 0; m < 4; ++m) { const int chunk = u.pm * 16 + ai * 8 + wr * 4 + m;
#pragma unroll
                    for (int bj = 0; bj < 2; ++bj)
#pragma unroll
                        for (int n = 0; n < 2; ++n) { const int g = (pn - 6) * 16 + bj * 8 + wc * 2 + n;
                            *(f16x4*)(Ug + (size_t)(g * 2048 + chunk) * 384 + fr * 16 + 4 * fq) = cvt4(acc[ai][bj][m][n]); } }
        } else {
            f16* base = SG + (pn - 8) * 256 + cl0;
#pragma unroll
            for (int ai = 0; ai < 2; ++ai)
#pragma unroll
                for (int m = 0; m < 4; ++m) { f16* rp = base + (size_t)(row0 + ai * 128 + m * 16) * 2048;
#pragma unroll
                    for (int bj = 0; bj < 2; ++bj)
#pragma unroll
                        for (int n = 0; n < 2; ++n) { const f32x4 v = acc[ai][bj][m][n]; f32x4 s; s[0] = sigmoidf_(v[0]); s[1] = sigmoidf_(v[1]); s[2] = sigmoidf_(v[2]); s[3] = sigmoidf_(v[3]);
                            *(f16x4*)(rp + bj * 128 + n * 16) = cvt4(s); } }
        }
    }
};
struct EpiSsm1 {
    float* S;
    __device__ __forceinline__ void operator()(AccRef acc, const Unit& u, int wr, int wc, int fr, int fq) const {
        const int row0 = u.pm * 256 + wr * 64 + fr;
#pragma unroll
        for (int ai = 0; ai < 2; ++ai)
#pragma unroll
            for (int m = 0; m < 4; ++m) { float* rp = S + (size_t)(row0 + ai * 128 + m * 16) * 128 + wc * 32 + 4 * fq;
#pragma unroll
                for (int n = 0; n < 2; ++n) *(f32x4*)(rp + n * 16) = acc[ai][0][m][n]; }
    }
};
struct EpiSsm3 {
    const f16* Ug; const float* dskip; f16* YS;
    __device__ __forceinline__ void operator()(AccRef acc, const Unit& u, int wr, int wc, int fr, int fq) const {
        const int g = u.pn, trow0 = u.pm * 256 + wr * 64 + fr;
        const f32x4 dv = *(const f32x4*)(dskip + 16 * g + 4 * fq);
#pragma unroll
        for (int ai = 0; ai < 2; ++ai)
#pragma unroll
            for (int m = 0; m < 4; ++m) { const int trow = trow0 + ai * 128 + m * 16, chunk = trow - g * 2048;
#pragma unroll
                for (int bj = 0; bj < 2; ++bj)
#pragma unroll
                    for (int n = 0; n < 2; ++n) { const int i = bj * 8 + wc * 2 + n;
                        const f16x4 uv = *(const f16x4*)(Ug + (size_t)trow * 384 + i * 16 + 4 * fq);
                        const f32x4 a = acc[ai][bj][m][n]; f32x4 y;
#pragma unroll
                        for (int j = 0; j < 4; ++j) y[j] = gelu_tanh(a[j] + dv[j] * (float)uv[j]);
                        *(f16x4*)(YS + (size_t)(chunk * 16 + i) * 512 + 16 * g + 4 * fq) = cvt4(y); } }
    }
};
struct EpiGlu {
    const f16* YS; const float* bias; f16* S5;
    __device__ __forceinline__ void operator()(AccRef acc, const Unit& u, int wr, int wc, int fr, int fq) const {
        const int row0 = u.pm * 256 + wr * 64 + fr, col0 = u.pn * 256 + wc * 32 + 4 * fq;
#pragma unroll
        for (int ai = 0; ai < 2; ++ai)
#pragma unroll
            for (int m = 0; m < 4; ++m) { const size_t ro = (size_t)(row0 + ai * 128 + m * 16) * 512;
#pragma unroll
                for (int bj = 0; bj < 2; ++bj)
#pragma unroll
                    for (int n = 0; n < 2; ++n) { const int col = col0 + bj * 128 + n * 16; const f32x4 bv = *(const f32x4*)(bias + col); const f16x4 yv = *(const f16x4*)(YS + ro + col);
                        const f32x4 a = acc[ai][bj][m][n]; f32x4 o;
#pragma unroll
                        for (int j = 0; j < 4; ++j) o[j] = (float)yv[j] * sigmoidf_(a[j] + bv[j]);
                        *(f16x4*)(S5 + ro + col) = cvt4(o); } }
    }
};
template <bool ADD> struct EpiUp {
    const f16* SG; int goff; const f16* T; f16* O;
    __device__ __forceinline__ void operator()(AccRef acc, const Unit& u, int wr, int wc, int fr, int fq) const {
        const int row0 = u.pm * 256 + wr * 64 + fr, col0 = u.pn * 256 + wc * 32 + 4 * fq;
#pragma unroll
        for (int ai = 0; ai < 2; ++ai)
#pragma unroll
            for (int m = 0; m < 4; ++m) { const size_t row = (size_t)(row0 + ai * 128 + m * 16);
#pragma unroll
                for (int bj = 0; bj < 2; ++bj)
#pragma unroll
                    for (int n = 0; n < 2; ++n) { const int col = col0 + bj * 128 + n * 16; const f16x4 gv = *(const f16x4*)(SG + row * 2048 + goff + col);
                        const f32x4 a = acc[ai][bj][m][n]; f32x4 o;
#pragma unroll
                        for (int j = 0; j < 4; ++j) o[j] = (float)gv[j] * a[j];
                        if (ADD) { const f16x4 tv = *(const f16x4*)(T + row * 1024 + col);
#pragma unroll
                            for (int j = 0; j < 4; ++j) o[j] += (float)tv[j]; }
                        *(f16x4*)(O + row * 1024 + col) = cvt4(o); } }
    }
};
struct EpiRes {
    const float* X; const float* gate; float* R;
    __device__ __forceinline__ void operator()(AccRef acc, const Unit& u, int wr, int wc, int fr, int fq) const {
        const int row0 = u.pm * 256 + wr * 64 + fr, col0 = u.pn * 256 + wc * 32 + 4 * fq;
        const float* gp = gate + (size_t)((u.pm * 256) >> 13) * NMOD;
        f32x4 gv[2][2];
#pragma unroll
        for (int bj = 0; bj < 2; ++bj)
#pragma unroll
            for (int n = 0; n < 2; ++n) gv[bj][n] = *(const f32x4*)(gp + col0 + bj * 128 + n * 16) + 1.0f;
#pragma unroll
        for (int ai = 0; ai < 2; ++ai)
#pragma unroll
            for (int m = 0; m < 4; ++m) { const size_t ro = (size_t)(row0 + ai * 128 + m * 16) * 1024;
#pragma unroll
                for (int bj = 0; bj < 2; ++bj)
#pragma unroll
                    for (int n = 0; n < 2; ++n) { const int col = col0 + bj * 128 + n * 16; const f32x4 xv = *(const f32x4*)(X + ro + col);
                        *(f32x4*)(R + ro + col) = xv * ALPHA + gv[bj][n] * acc[ai][bj][m][n]; } }
    }
};
struct EpiFfnIn {
    f16* H;
    __device__ __forceinline__ void operator()(AccRef acc, const Unit& u, int wr, int wc, int fr, int fq) const {
        const int row0 = u.pm * 256 + wr * 64 + fr, col0 = u.pn * 128 + wc * 32 + 4 * fq;
#pragma unroll
        for (int ai = 0; ai < 2; ++ai)
#pragma unroll
            for (int m = 0; m < 4; ++m) { f16* rp = H + (size_t)(row0 + ai * 128 + m * 16) * FH + col0;
#pragma unroll
                for (int n = 0; n < 2; ++n) { const f32x4 gt = acc[ai][0][m][n], up = acc[ai][1][m][n]; f32x4 o;
#pragma unroll
                    for (int j = 0; j < 4; ++j) o[j] = gt[j] * sigmoidf_(gt[j]) * up[j];
                    *(f16x4*)(rp + n * 16) = cvt4(o); } }
    }
};

__device__ __forceinline__ void attn_unit(const f16* __restrict__ Q, const f16* __restrict__ Kb, const f16* __restrict__ VT, f16* __restrict__ O, int bh, int qb, int lane) {
    const int b = bh >> 3, h = bh & 7, l32 = lane & 31, hi = lane >> 5, t0 = qb * 32, tq = t0 + l32;
    const size_t rowbase = (size_t)b * SEQ;
    f16x8 qf[4];
    { const f16* qp = Q + (rowbase + tq) * 512 + h * 64 + 8 * hi;
#pragma unroll
      for (int ks = 0; ks < 4; ++ks) qf[ks] = *(const f16x8*)(qp + 16 * ks); }
    f32x16 o0, o1;
#pragma unroll
    for (int r = 0; r < 16; ++r) { o0[r] = 0.f; o1[r] = 0.f; }
    float carry = 0.f;
    const f16* vbase = VT + (size_t)(bh * 64 + l32) * SEQ + 4 * hi;
    for (int kt = t0 >> 6; kt >= 0; --kt) {
        const int k0 = kt * 64;
        const f16* kp = Kb + (rowbase + k0 + l32) * 512 + h * 64 + 8 * hi;
        f32x16 z0, z1;
#pragma unroll
        for (int r = 0; r < 16; ++r) { z0[r] = 0.f; z1[r] = 0.f; }
#pragma unroll
        for (int ks = 0; ks < 4; ++ks) {
            const f16x8 a0 = *(const f16x8*)(kp + 16 * ks), a1 = *(const f16x8*)(kp + 32 * 512 + 16 * ks);
            z0 = __builtin_amdgcn_mfma_f32_32x32x16_f16(a0, qf[ks], z0, 0, 0, 0);
            z1 = __builtin_amdgcn_mfma_f32_32x32x16_f16(a1, qf[ks], z1, 0, 0, 0);
        }
        const bool diag = (k0 + 63 >= t0);
        f32x16 e0, e1;
#pragma unroll
        for (int r = 0; r < 16; ++r) {
            const int key = k0 + (r & 3) + 8 * (r >> 2) + 4 * hi;
            { const float z = z0[r] * 0.125f; const float sp = fmaxf(z, 0.f) + __logf(1.0f + __expf(-fabsf(z))); const bool ok = !diag || (key < tq);
              z0[r] = ok ? -sp : 0.f; e0[r] = ok ? (z - sp) : -1e30f; }
            { const float z = z1[r] * 0.125f; const float sp = fmaxf(z, 0.f) + __logf(1.0f + __expf(-fabsf(z))); const bool ok = !diag || (key + 32 < tq);
              z1[r] = ok ? -sp : 0.f; e1[r] = ok ? (z - sp) : -1e30f; }
        }
        float Gs[8], GP[8], ST[8];
#pragma unroll
        for (int g = 0; g < 4; ++g) { Gs[g] = (z0[4 * g] + z0[4 * g + 1]) + (z0[4 * g + 2] + z0[4 * g + 3]); Gs[4 + g] = (z1[4 * g] + z1[4 * g + 1]) + (z1[4 * g + 2] + z1[4 * g + 3]); }
#pragma unroll
        for (int i = 0; i < 8; ++i) GP[i] = __shfl_xor(Gs[i], 32);
        ST[7] = 0.f;
#pragma unroll
        for (int i = 6; i >= 0; --i) ST[i] = ST[i + 1] + (Gs[i + 1] + GP[i + 1]);
        const float tot = ST[0] + (Gs[0] + GP[0]);
#pragma unroll
        for (int i = 0; i < 8; ++i) {
            const float off = carry + ST[i] + (hi == 0 ? GP[i] : 0.f);
            if (i < 4) { const int r = 4 * i;
                const float a3 = off, a2 = a3 + z0[r + 3], a1 = a2 + z0[r + 2], a0 = a1 + z0[r + 1];
                e0[r] = __expf(e0[r] + a0); e0[r + 1] = __expf(e0[r + 1] + a1); e0[r + 2] = __expf(e0[r + 2] + a2); e0[r + 3] = __expf(e0[r + 3] + a3);
            } else { const int r = 4 * (i - 4);
                const float a3 = off, a2 = a3 + z1[r + 3], a1 = a2 + z1[r + 2], a0 = a1 + z1[r + 1];
                e1[r] = __expf(e1[r] + a0); e1[r + 1] = __expf(e1[r + 1] + a1); e1[r + 2] = __expf(e1[r + 2] + a2); e1[r + 3] = __expf(e1[r + 3] + a3);
            }
        }
        carry += tot;
#pragma unroll
        for (int j = 0; j < 4; ++j) {
            f16x8 wb;
#pragma unroll
            for (int i = 0; i < 8; ++i) wb[i] = (f16)((j < 2) ? e0[8 * (j & 1) + i] : e1[8 * (j & 1) + i]);
            const f16* vp = vbase + k0 + 16 * j;
            const f16x4 va0 = *(const f16x4*)(vp), va1 = *(const f16x4*)(vp + 8);
            const f16x4 vb0 = *(const f16x4*)(vp + (size_t)32 * SEQ), vb1 = *(const f16x4*)(vp + (size_t)32 * SEQ + 8);
            f16x8 fa, fb;
#pragma unroll
            for (int i = 0; i < 4; ++i) { fa[i] = va0[i]; fa[4 + i] = va1[i]; fb[i] = vb0[i]; fb[4 + i] = vb1[i]; }
            o0 = __builtin_amdgcn_mfma_f32_32x32x16_f16(fa, wb, o0, 0, 0, 0);
            o1 = __builtin_amdgcn_mfma_f32_32x32x16_f16(fb, wb, o1, 0, 0, 0);
        }
        if (__all(carry < -104.0f)) break;
    }
    f16* op = O + (rowbase + tq) * 512 + h * 64 + 4 * hi;
#pragma unroll
    for (int g = 0; g < 4; ++g) {
        f32x4 a, c;
#pragma unroll
        for (int j = 0; j < 4; ++j) { a[j] = o0[4 * g + j]; c[j] = o1[4 * g + j]; }
        *(f16x4*)(op + 8 * g) = cvt4(a); *(f16x4*)(op + 32 + 8 * g) = cvt4(c);
    }
}

__device__ __forceinline__ void row_stats(const f32x4 (&v)[4], float& mean, float& rstd) {
    float s = 0.f;
#pragma unroll
    for (int j = 0; j < 4; ++j) s += (v[j][0] + v[j][1]) + (v[j][2] + v[j][3]);
    mean = wave_sum(s) * (1.f / D);
    float q = 0.f;
#pragma unroll
    for (int j = 0; j < 4; ++j) { const f32x4 d = v[j] - mean; q += (d[0] * d[0] + d[1] * d[1]) + (d[2] * d[2] + d[3] * d[3]); }
    rstd = 1.0f / sqrtf(wave_sum(q) * (1.f / D) + LN_EPS);
}
__device__ __forceinline__ void row_mod(const float* xrow, const float* sh, const float* sc, f16* orow, int lane) {
    f32x4 v[4];
#pragma unroll
    for (int j = 0; j < 4; ++j) v[j] = *(const f32x4*)(xrow + 4 * lane + 256 * j);
    float mean, rstd; row_stats(v, mean, rstd);
#pragma unroll
    for (int j = 0; j < 4; ++j) { const int c = 4 * lane + 256 * j; const f32x4 s1 = *(const f32x4*)(sc + c) + 1.0f, s0 = *(const f32x4*)(sh + c);
        *(f16x4*)(orow + c) = cvt4((v[j] - mean) * rstd * s1 + s0); }
}
__device__ __forceinline__ void row_ln2(const float* rrow, const float* lg, const float* lb, float* xout, bool wh, const float* sh, const float* sc, f16* orow, int lane) {
    f32x4 v[4];
#pragma unroll
    for (int j = 0; j < 4; ++j) v[j] = *(const f32x4*)(rrow + 4 * lane + 256 * j);
    float mean, rstd; row_stats(v, mean, rstd);
#pragma unroll
    for (int j = 0; j < 4; ++j) { const int c = 4 * lane + 256 * j; v[j] = (v[j] - mean) * rstd * *(const f32x4*)(lg + c) + *(const f32x4*)(lb + c);
        *(f32x4*)(xout + c) = v[j]; }
    if (wh) {
        row_stats(v, mean, rstd);
#pragma unroll
        for (int j = 0; j < 4; ++j) { const int c = 4 * lane + 256 * j; const f32x4 s1 = *(const f32x4*)(sc + c) + 1.0f, s0 = *(const f32x4*)(sh + c);
            *(f16x4*)(orow + c) = cvt4((v[j] - mean) * rstd * s1 + s0); }
    }
}

__device__ __forceinline__ void transpose_item(const float* W, int K, int N, f16* WT, int mode, LAS float* scr, int item, int lane) {
    const int nblk = N / 32, kb = item / nblk, nb = item % nblk, k0 = 64 * kb, n0 = 32 * nb;
#pragma unroll 8
    for (int i = 0; i < 32; ++i) { const int kk = 2 * i + (lane >> 5); scr[kk * 33 + (lane & 31)] = W[(size_t)(k0 + kk) * N + n0 + (lane & 31)]; }
    asm volatile("s_waitcnt lgkmcnt(0)" ::: "memory");
    const int c = lane & 7;
#pragma unroll
    for (int j = 0; j < 4; ++j) { const int n = (lane >> 3) + 8 * j; const LAS float* s = scr + (8 * c) * 33 + n;
        f16x8 o;
#pragma unroll
        for (int e = 0; e < 8; ++e) o[e] = (f16)s[e * 33];
        const int nn = n0 + n; int drow = nn;
        if (mode == 1) { const int hh = nn < FH ? nn : nn - FH; drow = (hh >> 7) * 256 + (nn < FH ? 0 : 128) + (hh & 127); }
        *(f16x8*)(WT + (size_t)drow * K + k0 + 8 * c) = o; }
    asm volatile("s_waitcnt lgkmcnt(0)" ::: "memory");
}


#define XB_TMO      128
#define XB_XCNT(j)  (256  + 64 * (j))
#define XB_XSUB(j)  (1280 + 64 * (j))
#define XB_XGEN(j)  (2304 + 64 * (j))
#define XB_TOP      3328
#define XB_TOPGEN   3392
#define XCD_BAR_WORDS 3456
#define XB_SPIN_CAP (1u << 22)
__device__ __forceinline__ unsigned xb_ld(unsigned* p)              { return __hip_atomic_load(p, __ATOMIC_RELAXED, __HIP_MEMORY_SCOPE_AGENT); }
__device__ __forceinline__ unsigned xb_add(unsigned* p, unsigned v) { return __hip_atomic_fetch_add(p, v, __ATOMIC_RELAXED, __HIP_MEMORY_SCOPE_AGENT); }
__device__ __forceinline__ unsigned xb_xcc_id() { return (unsigned)__builtin_amdgcn_s_getreg((3 << 11) | 20) & 0xFu; }
#define XB_SPIN(cond, bar) do { unsigned _sp = 0; while (cond) { __builtin_amdgcn_s_sleep(1); \
    if ((++_sp & 255u) == 0u) { if (xb_ld(&(bar)[XB_TMO])) break; if (_sp > XB_SPIN_CAP) { atomicAdd(&(bar)[XB_TMO], 1u); break; } } } } while (0)
struct XcdBarrier { unsigned* bar; unsigned x; volatile LAS unsigned* st; };
__device__ __forceinline__ void xcd_barrier_complete(unsigned* bar, unsigned x, unsigned& nloc, unsigned& nx) {
    const unsigned G = gridDim.x * gridDim.y * gridDim.z;
    unsigned sum, cnt, mine, sp = 0u;
    for (;;) {
        sum = 0u; cnt = 0u; mine = 0u;
#pragma unroll
        for (unsigned j = 0; j < 16; ++j) { const unsigned c = xb_ld(&bar[XB_XCNT(j)]); sum += c; cnt += (c > 0u) ? 1u : 0u; mine = (j == x) ? c : mine; }
        if (sum == G) break;
        __builtin_amdgcn_s_sleep(1);
        if ((++sp & 255u) == 0u) { if (xb_ld(&bar[XB_TMO])) break; if (sp > XB_SPIN_CAP) { atomicAdd(&bar[XB_TMO], 1u); break; } }
    }
    nloc = mine > 0u ? mine : 1u; nx = cnt > 0u ? cnt : 1u;
}
__device__ __forceinline__ void xcd_barrier(const XcdBarrier& b, bool t0) {
    asm volatile("s_waitcnt vmcnt(0)" ::: "memory");
    __syncthreads();
    if (t0) {
        unsigned* bar = b.bar;
        __builtin_amdgcn_s_waitcnt(0);
        unsigned nloc = b.st[0], nx = b.st[1];
        if (nloc == 0u) { xcd_barrier_complete(bar, b.x, nloc, nx); b.st[0] = nloc; b.st[1] = nx; }
        const unsigned old = xb_add(&bar[XB_XSUB(b.x)], 1u);
        const unsigned gen = old / nloc;
        if (old + 1u == (gen + 1u) * nloc) {
            __builtin_amdgcn_fence(__ATOMIC_RELEASE, "agent");
            asm volatile("s_waitcnt vmcnt(0)" ::: "memory");
            const unsigned og = xb_add(&bar[XB_TOP], 1u);
            const unsigned tg = og / nx;
            if (og + 1u == (tg + 1u) * nx) xb_add(&bar[XB_TOPGEN], 1u);
            else XB_SPIN(xb_ld(&bar[XB_TOPGEN]) == tg, bar);
            __builtin_amdgcn_fence(__ATOMIC_ACQUIRE, "agent");
            xb_add(&bar[XB_XGEN(b.x)], 1u);
            asm volatile("s_waitcnt vmcnt(0)" ::: "memory");
        } else {
            XB_SPIN(xb_ld(&bar[XB_XGEN(b.x)]) == gen, bar);
            __builtin_amdgcn_fence(__ATOMIC_ACQUIRE, "agent");
            asm volatile("s_waitcnt vmcnt(0)" ::: "memory");
        }
    }
    __syncthreads();
}

struct Args { const float* in[24]; float* out; unsigned char* ws; };
enum { I_X = 0, I_C, I_WADA, I_BADA, I_WIN, I_WSBUP, I_ARE, I_AIM, I_LOGDT, I_BRE, I_BIM, I_CRE, I_CIM, I_DSKIP, I_WGLU, I_BGLU, I_WSSMUP, I_WOUT, I_LN1G, I_LN1B, I_WFIN, I_WFOUT, I_LN2G, I_LN2B };

template <class T> __device__ __forceinline__ T* opq(T* p) { asm volatile("" : "+s"(p)); return p; }
#define PHASE_BEGIN unsigned char* ws = opq(a.ws); float* DOUT = opq(a.out); int wv_ = wave_s; asm volatile("" : "+s"(wv_)); int tid = (wv_ << 6) | (int)__builtin_amdgcn_mbcnt_hi(~0u, __builtin_amdgcn_mbcnt_lo(~0u, 0u)); asm volatile("" : "+v"(tid)); \
    const int lane = tid & 63, wave = __builtin_amdgcn_readfirstlane(tid >> 6), gw = bid * 8 + wave, gtid = bid * 512 + tid; (void)lane; (void)wave; (void)gw; (void)gtid; (void)DOUT; (void)ws;

__global__ void __launch_bounds__(512, 2) mk_fwd(Args a) {
    extern __shared__ __attribute__((aligned(16))) unsigned char lds_raw[];
    LAS unsigned char* lds = (LAS unsigned char*)lds_raw;
    cg::grid_group grid = cg::this_grid();
    const int G = gridDim.x, bid = blockIdx.x, NGW = G * 8, NT = G * 512;
    const int wave_s = __builtin_amdgcn_readfirstlane((int)threadIdx.x >> 6);
    const unsigned xcc_s = xb_xcc_id();
    if (threadIdx.x < 2) ((volatile LAS unsigned*)(lds + 131072))[threadIdx.x] = 0u;
    if (threadIdx.x == 0) (void)xb_add((unsigned*)(a.ws + WS_BAR) + XB_XCNT(xcc_s), 1u);
    __syncthreads();
#define is_t0() (wave_s == 0 && __builtin_amdgcn_mbcnt_hi(~0u, __builtin_amdgcn_mbcnt_lo(~0u, 0u)) == 0u)

    {
        PHASE_BEGIN
        float* mod = (float*)(ws + WS_MOD);
        LAS float* scr = (LAS float*)(lds + wave * 16384);
        constexpr int I0 = 16 * 128, I1 = 8 * 32, I2 = 8 * 16, I3 = 8 * 32, I4 = 16 * 32, I5 = 16 * 176, I6 = 44 * 32, IL = I0 + I1 + I2 + I3 + I4 + I5 + I6;
        for (int it = gw; it < 2 * IL; it += NGW) {
            const int l = it / IL; int r = it % IL; unsigned char* wl = ws + (size_t)l * WS_WL;
            if (r < I0) { transpose_item(a.in[I_WIN] + (size_t)l * D * INC, D, INC, (f16*)(wl + W_IN), 0, scr, r, lane); continue; } r -= I0;
            if (r < I1) { transpose_item(a.in[I_WSBUP] + (size_t)l * 512 * D, 512, D, (f16*)(wl + W_SBUP), 0, scr, r, lane); continue; } r -= I1;
            if (r < I2) { transpose_item(a.in[I_WGLU] + (size_t)l * 512 * 512, 512, 512, (f16*)(wl + W_GLU), 0, scr, r, lane); continue; } r -= I2;
            if (r < I3) { transpose_item(a.in[I_WSSMUP] + (size_t)l * 512 * D, 512, D, (f16*)(wl + W_SSMUP), 0, scr, r, lane); continue; } r -= I3;
            if (r < I4) { transpose_item(a.in[I_WOUT] + (size_t)l * D * D, D, D, (f16*)(wl + W_OUT), 0, scr, r, lane); continue; } r -= I4;
            if (r < I5) { transpose_item(a.in[I_WFIN] + (size_t)l * D * 2 * FH, D, 2 * FH, (f16*)(wl + W_FIN), 1, scr, r, lane); continue; } r -= I5;
            transpose_item(a.in[I_WFOUT] + (size_t)l * FH * D, FH, D, (f16*)(wl + W_FOUT), 0, scr, r, lane);
        }
        for (int it = gw; it < 2 * 96 * 16; it += NGW) {
            const int l = it / 1536, r = it % 1536, jb = r >> 4, kc = r & 15, j = jb * 64 + lane;
            const float* w = a.in[I_WADA] + (size_t)l * D * NMOD + (size_t)(kc * 64) * NMOD + j;
            const float* cc = a.in[I_C] + kc * 64;
            float a0 = 0.f, a1 = 0.f, a2 = 0.f, a3 = 0.f;
#pragma unroll 1
            for (int k0 = 0; k0 < 64; k0 += 16) {
                float wv[16];
#pragma unroll
                for (int q = 0; q < 16; ++q) wv[q] = w[(size_t)(k0 + q) * NMOD];
#pragma unroll
                for (int q = 0; q < 16; ++q) {
                    const float c0 = cc[k0 + q], c1 = cc[D + k0 + q], c2 = cc[2 * D + k0 + q], c3 = cc[3 * D + k0 + q];
                    a0 += c0 * sigmoidf_(c0) * wv[q]; a1 += c1 * sigmoidf_(c1) * wv[q]; a2 += c2 * sigmoidf_(c2) * wv[q]; a3 += c3 * sigmoidf_(c3) * wv[q];
                }
            }
            if (kc == 0) { const float bv = a.in[I_BADA][l * NMOD + j]; a0 += bv; a1 += bv; a2 += bv; a3 += bv; }
            atomicAdd(mod + (size_t)(l * 4 + 0) * NMOD + j, a0); atomicAdd(mod + (size_t)(l * 4 + 1) * NMOD + j, a1);
            atomicAdd(mod + (size_t)(l * 4 + 2) * NMOD + j, a2); atomicAdd(mod + (size_t)(l * 4 + 3) * NMOD + j, a3);
        }
        for (int e = gtid; e < 2 * 32 * 64 * 16; e += NT) {
            const int j = e & 15, p = (e >> 4) & 63, lg = e >> 10, l = lg >> 5, g = lg & 31;
            const float are = a.in[I_ARE][lg * 64 + p], aim = a.in[I_AIM][lg * 64 + p], dt = __expf(a.in[I_LOGDT][lg]);
            const f32x4* brp = (const f32x4*)(a.in[I_BRE] + (size_t)(lg * 64 + p) * 16); const f32x4* bip = (const f32x4*)(a.in[I_BIM] + (size_t)(lg * 64 + p) * 16);
            f32x4 br[4], bi[4];
#pragma unroll
            for (int q = 0; q < 4; ++q) { br[q] = brp[q]; bi[q] = bip[q]; }
            float lr, li; cexp_fast(are * dt, aim * dt, 1.0f, lr, li);
            const float nr = lr - 1.0f, ni = li, den = 1.0f / (are * are + aim * aim);
            const float cr = (nr * are + ni * aim) * den, ci_ = (ni * are - nr * aim) * den;
            float pr, pi; cexp_fast(are * dt, aim * dt, (float)(15 - j), pr, pi);
            const float qr = pr * cr - pi * ci_, qi = pr * ci_ + pi * cr;
            f16x8 o[4];
#pragma unroll
            for (int q = 0; q < 4; ++q)
#pragma unroll
                for (int t = 0; t < 4; ++t) { o[q >> 1][(q & 1) * 4 + t] = (f16)(qr * br[q][t] - qi * bi[q][t]); o[2 + (q >> 1)][(q & 1) * 4 + t] = (f16)(qr * bi[q][t] + qi * br[q][t]); }
            f16* w1 = (f16*)(ws + WS_SSM + (size_t)l * WS_SSML + S_W1) + ((size_t)(g * 256 + p)) * 256 + 16 * j;
            *(f16x8*)(w1) = o[0]; *(f16x8*)(w1 + 8) = o[1]; *(f16x8*)(w1 + 64 * 256) = o[2]; *(f16x8*)(w1 + 64 * 256 + 8) = o[3];
        }
        for (int e = gtid; e < 2 * 32 * 128 * 32; e += NT) {
            const int c8 = e & 31, row = 128 + ((e >> 5) & 127), lg = e >> 12, l = lg >> 5, g = lg & 31;
            f16x8 z;
#pragma unroll
            for (int t = 0; t < 8; ++t) z[t] = (f16)0.f;
            *(f16x8*)((f16*)(ws + WS_SSM + (size_t)l * WS_SSML + S_W1) + ((size_t)(g * 256 + row)) * 256 + 8 * c8) = z;
        }
        for (int e = gtid; e < 2 * 32 * 16 * 64; e += NT) {
            const int p = e & 63, i = (e >> 6) & 15, lg = e >> 10, l = lg >> 5, g = lg & 31;
            const float are = a.in[I_ARE][lg * 64 + p], aim = a.in[I_AIM][lg * 64 + p], dt = __expf(a.in[I_LOGDT][lg]);
            float cr[16], cim[16];
#pragma unroll
            for (int co = 0; co < 16; ++co) { cr[co] = a.in[I_CRE][(size_t)(lg * 16 + co) * 64 + p]; cim[co] = a.in[I_CIM][(size_t)(lg * 16 + co) * 64 + p]; }
            float pr, pi; cexp_fast(are * dt, aim * dt, (float)(i + 1), pr, pi);
            f16* tw = (f16*)(ws + WS_SSM + (size_t)l * WS_SSML + S_TW) + ((size_t)(g * 256 + 16 * i)) * 384 + 256 + p;
#pragma unroll
            for (int co = 0; co < 16; ++co) { tw[(size_t)co * 384] = (f16)(cr[co] * pr - cim[co] * pi); tw[(size_t)co * 384 + 64] = (f16)(-(cr[co] * pi + cim[co] * pr)); }
        }
        for (int e = gtid; e < 2 * 32 * 16 * 256; e += NT) {
            const int ci = e & 15, co = (e >> 4) & 15, d = (e >> 8) & 15, lg = e >> 12;
            const float dt = __expf(a.in[I_LOGDT][lg]);
            float accv = 0.f;
#pragma unroll 8
            for (int p = 0; p < 64; ++p) {
                const float are = a.in[I_ARE][lg * 64 + p], aim = a.in[I_AIM][lg * 64 + p];
                const float c_r = a.in[I_CRE][(size_t)(lg * 16 + co) * 64 + p], c_i = a.in[I_CIM][(size_t)(lg * 16 + co) * 64 + p];
                const float b_r = a.in[I_BRE][(size_t)(lg * 64 + p) * 16 + ci], b_i = a.in[I_BIM][(size_t)(lg * 64 + p) * 16 + ci];
                float lr, li; cexp_fast(are * dt, aim * dt, 1.0f, lr, li);
                const float nr = lr - 1.0f, ni = li, den = 1.0f / (are * are + aim * aim);
                const float cr = (nr * are + ni * aim) * den, ci_ = (ni * are - nr * aim) * den;
                float pr, pi; cexp_fast(are * dt, aim * dt, (float)d, pr, pi);
                const float qr = pr * cr - pi * ci_, qi = pr * ci_ + pi * cr;
                const float er = c_r * qr - c_i * qi, ei = c_r * qi + c_i * qr;
                accv += er * b_r - ei * b_i;
            }
            ((float*)(ws + WS_SSM + (size_t)(lg >> 5) * WS_SSML + S_KD))[e & 131071] = accv;
        }
    }
    grid.sync();
    {
        PHASE_BEGIN
        const float* mod = (const float*)(ws + WS_MOD); f16* XN = (f16*)(ws + WS_XN);
        for (int rep_ = 0; rep_ < REP_ROW; ++rep_) for (int m = gw; m < M; m += NGW) { const int b = m >> 13; const float* mb = mod + (size_t)b * NMOD;
            row_mod(a.in[I_X] + (size_t)m * D, mb, mb + D, XN + (size_t)m * D, lane); }
        for (int e = gtid; e < 2 * 32 * 256 * 32; e += NT) {
            const int c8 = e & 31, row = (e >> 5) & 255, lg = e >> 13, l = lg >> 5, g = lg & 31;
            const int i = row >> 4, co = row & 15, j = c8 >> 1, ci0 = (c8 & 1) * 8;
            f16x8 o;
            if (j <= i) { const f32x4* kp = (const f32x4*)((const float*)(ws + WS_SSM + (size_t)l * WS_SSML + S_KD) + ((size_t)((g * 16 + (i - j)) * 16 + co)) * 16 + ci0);
                const f32x4 k0 = kp[0], k1 = kp[1];
#pragma unroll
                for (int t = 0; t < 4; ++t) { o[t] = (f16)k0[t]; o[4 + t] = (f16)k1[t]; } }
            else {
#pragma unroll
                for (int t = 0; t < 8; ++t) o[t] = (f16)0.f; }
            *(f16x8*)((f16*)(ws + WS_SSM + (size_t)l * WS_SSML + S_TW) + ((size_t)(g * 256 + row)) * 384 + 8 * c8) = o;
        }
    }
    GSYNC();

#pragma unroll 1
    for (int l = 0; l < 2; ++l) {
        { PHASE_BEGIN
          pg8::Gemm g{(const f16*)(ws + WS_XN), (const f16*)(ws + (size_t)l * WS_WL + W_IN), D, D, D}; pg8::StaticOrder S; S.init(M, INC, G, bid);
          EpiInProj E{(f16*)(ws + WS_Q), (f16*)(ws + WS_K), (f16*)(ws + WS_VT), (f16*)(ws + WS_UG), (f16*)(ws + WS_SG)};
          pg8::gemm_phase<EpiInProj, pg8::StaticOrder, true>(lds, g, S, E, wave); }
        GSYNC();
        { PHASE_BEGIN
          for (int rep_ = 0; rep_ < REP_ATTN; ++rep_) for (int u = gw; u < 8192; u += NGW) attn_unit((const f16*)(ws + WS_Q), (const f16*)(ws + WS_K), (const f16*)(ws + WS_VT), (f16*)(ws + WS_O), u >> 8, u & 255, lane); }
        __syncthreads();
        { PHASE_BEGIN
          pg8::Gemm g{(const f16*)(ws + WS_UG), (const f16*)(ws + WS_SSM + (size_t)l * WS_SSML + S_W1), 256, 384, 256}; pg8::GroupOrder S{G, bid};
          EpiSsm1 E{(float*)(ws + WS_S)};
          pg8::gemm_phase<EpiSsm1, pg8::GroupOrder, false>(lds, g, S, E, wave); }
        GSYNC();
        { PHASE_BEGIN
          for (int rep_ = 0; rep_ < REP_SCAN; ++rep_) if (wave == 0 && bid < 128) {
            const float* Sb = (const float*)(ws + WS_S); f16* Ug = (f16*)(ws + WS_UG);
            const int b = bid >> 5, g = bid & 31, lg = l * 32 + g, p = lane;
            const float are = a.in[I_ARE][lg * 64 + p], aim = a.in[I_AIM][lg * 64 + p], dt = expf(a.in[I_LOGDT][lg]);
            float ar, ai; cexp_k(are * dt, aim * dt, 16.0f, ar, ai);
            float sr = 0.f, si = 0.f;
            const size_t row0 = (size_t)g * 2048 + (size_t)b * 512;
            for (int c0 = 0; c0 < 512; c0 += 8) {
                float vr[8], vi[8];
#pragma unroll
                for (int q = 0; q < 8; ++q) { const float* sp = Sb + (row0 + c0 + q) * 128 + p; vr[q] = sp[0]; vi[q] = sp[64]; }
#pragma unroll
                for (int q = 0; q < 8; ++q) {
                    f16* up = Ug + (row0 + c0 + q) * 384 + 256 + p; up[0] = (f16)sr; up[64] = (f16)si;
                    const float nr = ar * sr - ai * si + vr[q], ni = ar * si + ai * sr + vi[q]; sr = nr; si = ni;
                }
            }
          } }
        GSYNC();
        { PHASE_BEGIN
          pg8::Gemm g{(const f16*)(ws + WS_UG), (const f16*)(ws + WS_SSM + (size_t)l * WS_SSML + S_TW), 384, 384, 384}; pg8::GroupOrder S{G, bid};
          EpiSsm3 E{(const f16*)(ws + WS_UG), a.in[I_DSKIP] + l * 512, (f16*)(ws + WS_YS)};
          pg8::gemm_phase<EpiSsm3, pg8::GroupOrder, false>(lds, g, S, E, wave); }
        GSYNC();
        { PHASE_BEGIN
          pg8::Gemm g{(const f16*)(ws + WS_YS), (const f16*)(ws + (size_t)l * WS_WL + W_GLU), 512, 512, 512}; pg8::StaticOrder S; S.init(M, 512, G, bid);
          EpiGlu E{(const f16*)(ws + WS_YS), a.in[I_BGLU] + l * 512, (f16*)(ws + WS_S5)};
          pg8::gemm_phase<EpiGlu, pg8::StaticOrder, true>(lds, g, S, E, wave); }
        { PHASE_BEGIN
          pg8::Gemm g{(const f16*)(ws + WS_O), (const f16*)(ws + (size_t)l * WS_WL + W_SBUP), 512, 512, 512}; pg8::StaticOrder S; S.init(M, D, G, bid);
          EpiUp<false> E{(const f16*)(ws + WS_SG), 0, nullptr, (f16*)(ws + WS_TMP)};
          pg8::gemm_phase<EpiUp<false>, pg8::StaticOrder, true>(lds, g, S, E, wave); }
        GSYNC();
        { PHASE_BEGIN
          pg8::Gemm g{(const f16*)(ws + WS_S5), (const f16*)(ws + (size_t)l * WS_WL + W_SSMUP), 512, 512, 512}; pg8::StaticOrder S; S.init(M, D, G, bid);
          EpiUp<true> E{(const f16*)(ws + WS_SG), 1024, (const f16*)(ws + WS_TMP), (f16*)(ws + WS_MRG)};
          pg8::gemm_phase<EpiUp<true>, pg8::StaticOrder, true>(lds, g, S, E, wave); }
        GSYNC();
        { PHASE_BEGIN
          pg8::Gemm g{(const f16*)(ws + WS_MRG), (const f16*)(ws + (size_t)l * WS_WL + W_OUT), D, D, D}; pg8::StaticOrder S; S.init(M, D, G, bid);
          EpiRes E{l == 0 ? a.in[I_X] : (const float*)DOUT, (const float*)(ws + WS_MOD) + (size_t)l * 4 * NMOD + 2 * D, DOUT};
          pg8::gemm_phase<EpiRes, pg8::StaticOrder, true>(lds, g, S, E, wave); }
        GSYNC();
        { PHASE_BEGIN
          const float* modl = (const float*)(ws + WS_MOD) + (size_t)l * 4 * NMOD; f16* XN = (f16*)(ws + WS_XN);
          for (int m = gw; m < M; m += NGW) { const int b = m >> 13; const float* mb = modl + (size_t)b * NMOD;
            row_ln2(DOUT + (size_t)m * D, a.in[I_LN1G] + l * D, a.in[I_LN1B] + l * D, DOUT + (size_t)m * D, true, mb + 3 * D, mb + 4 * D, XN + (size_t)m * D, lane); } }
        GSYNC();
        { PHASE_BEGIN
          pg8::Gemm g{(const f16*)(ws + WS_XN), (const f16*)(ws + (size_t)l * WS_WL + W_FIN), D, D, D}; pg8::StaticOrder S; S.init(M, 2 * FH, G, bid);
          EpiFfnIn E{(f16*)(ws + WS_H)};
          pg8::gemm_phase<EpiFfnIn, pg8::StaticOrder, true>(lds, g, S, E, wave); }
        GSYNC();
        { PHASE_BEGIN
          pg8::Gemm g{(const f16*)(ws + WS_H), (const f16*)(ws + (size_t)l * WS_WL + W_FOUT), FH, FH, FH}; pg8::StaticOrder S; S.init(M, D, G, bid);
          EpiRes E{DOUT, (const float*)(ws + WS_MOD) + (size_t)l * 4 * NMOD + 5 * D, (float*)(ws + WS_R2)};
          pg8::gemm_phase<EpiRes, pg8::StaticOrder, true>(lds, g, S, E, wave); }
        GSYNC();
        { PHASE_BEGIN
          const float* modn = (const float*)(ws + WS_MOD) + (size_t)4 * NMOD; f16* XN = (f16*)(ws + WS_XN); const float* R2 = (const float*)(ws + WS_R2);
          for (int m = gw; m < M; m += NGW) { const int b = m >> 13; const float* mb = modn + (size_t)b * NMOD;
            row_ln2(R2 + (size_t)m * D, a.in[I_LN2G] + l * D, a.in[I_LN2B] + l * D, DOUT + (size_t)m * D, l == 0, mb, mb + D, XN + (size_t)m * D, lane); } }
        if (l == 0) GSYNC();
    }
}

extern "C" void kernel_launch(void* const* d_in, const int* in_sizes, int n_in, void* d_out, int out_size, void* d_ws, size_t ws_size, hipStream_t stream) {
    static int grid = 0;
    if (grid == 0) {
        if (n_in != 24 || in_sizes[0] != M * D || out_size != M * D || ws_size < WS_NEED) { fprintf(stderr, "kernel_launch: unexpected shapes (n_in %d, in0 %d, out %d, ws %zu)\n", n_in, n_in > 0 ? in_sizes[0] : -1, out_size, ws_size); grid = -1; return; }
        int dev = 0, cus = 0, per_cu = 0;
        if (hipGetDevice(&dev) != hipSuccess || hipDeviceGetAttribute(&cus, hipDeviceAttributeMultiprocessorCount, dev) != hipSuccess) { grid = -1; return; }
        if (hipFuncSetAttribute((const void*)mk_fwd, hipFuncAttributeMaxDynamicSharedMemorySize, LDS_BYTES) != hipSuccess) { fprintf(stderr, "kernel_launch: hipFuncSetAttribute failed\n"); grid = -1; return; }
        if (hipOccupancyMaxActiveBlocksPerMultiprocessor(&per_cu, (const void*)mk_fwd, 512, LDS_BYTES) != hipSuccess || per_cu < 1) { fprintf(stderr, "kernel_launch: occupancy query says %d blocks per CU\n", per_cu); per_cu = 1; }
        (void)hipGetLastError();
        grid = cus * 1;
    }
    if (grid < 0) return;
    (void)hipMemsetAsync((char*)d_ws + WS_MOD, 0, ZERO_BYTES, stream);
    Args a{};
    for (int i = 0; i < 24; ++i) a.in[i] = (const float*)d_in[i];
    a.out = (float*)d_out; a.ws = (unsigned char*)d_ws;
    void* args[] = {&a};
    hipError_t e = hipLaunchCooperativeKernel((const void*)mk_fwd, dim3(grid), dim3(512), args, LDS_BYTES, stream);
    if (e != hipSuccess) fprintf(stderr, "cooperative launch failed: %s (grid %d)\n", hipGetErrorString(e), grid);
}
```
